# Optimizing an MI355X kernel written in HIP

```python
import math
import jax, jax.numpy as jnp
from jax import lax
import numpy as np

D_MODEL = 1024
BATCH = 4
SEQ = 8192
DEPTH = 2

GRID_W = 64
CTX_LEN = 256
N_HEADS = 4
HEAD_DIM = 64
MIX_W = N_HEADS * HEAD_DIM
CHUNK = 128
ROPE_BASE = 10000.0
EPS = 1e-6
RET_DECAY_EXP0 = 5.0
SG_CHUNK = 128
CONV_W = 5
Q_LORA = 256
KV_LORA = 128
NOPE_DIM = 64
ROPE_DIM = 32
V_DIM = 64
N_EXPERTS = 16
N_GROUPS = 4
EXPERTS_PER_GROUP = N_EXPERTS // N_GROUPS
TOP_K = 2
D_EXPERT = 256
N_BRANCH = 4

RET_COLS = 4 * MIX_W
SG_COLS = 2 * MIX_W
DN_COLS = 4 * MIX_W + 4 * N_HEADS
MLA_COLS = Q_LORA + KV_LORA + ROPE_DIM
GATE_COLS = N_BRANCH * D_MODEL
OFF_RET = 0
OFF_SG = OFF_RET + RET_COLS
OFF_DN = OFF_SG + SG_COLS
OFF_MLA = OFF_DN + DN_COLS
OFF_GATE = OFF_MLA + MLA_COLS
IN_COLS = OFF_GATE + GATE_COLS

kernel_name = "hybrid_diffusion_ctx_prefix_block"


def rmsnorm(x, g):
    xf = x.astype(jnp.float32)
    xf = xf * lax.rsqrt(jnp.mean(xf * xf, axis=-1, keepdims=True) + EPS)
    return (xf * g.astype(jnp.float32)).astype(x.dtype)


def layernorm_noaffine(x):
    xf = x.astype(jnp.float32)
    mu = jnp.mean(xf, axis=-1, keepdims=True)
    var = jnp.mean(jnp.square(xf - mu), axis=-1, keepdims=True)
    return ((xf - mu) * lax.rsqrt(var + EPS)).astype(x.dtype)


def l2norm(x):
    xf = x.astype(jnp.float32)
    return xf * lax.rsqrt(jnp.sum(xf * xf, axis=-1, keepdims=True) + EPS)


def modulate(h, shift, scale):
    return h * (1 + scale) + shift


def adaln(cond, w, b):
    m = jax.nn.silu(cond) @ w + b
    m = m.reshape(m.shape[0], 1, 6, D_MODEL)
    return tuple(m[:, :, i] for i in range(6))


def rope_angles(pos, dim):
    half = dim // 2
    inv = ROPE_BASE ** (-jnp.arange(half, dtype=jnp.float32) / half)
    return pos.astype(jnp.float32)[:, None] * inv[None, :]


def rotate(x, ang):
    half = x.shape[-1] // 2
    cos = jnp.cos(ang).astype(x.dtype)
    sin = jnp.sin(ang).astype(x.dtype)
    x1, x2 = x[..., :half], x[..., half:]
    return jnp.concatenate([x1 * cos - x2 * sin, x2 * cos + x1 * sin], axis=-1)


def rotate_2d(x, ang_row, ang_col):
    half = x.shape[-1] // 2
    return jnp.concatenate([rotate(x[..., :half], ang_row), rotate(x[..., half:], ang_col)], axis=-1)


def to_heads(t):
    b_, n_, w_ = t.shape
    return t.reshape(b_, n_, N_HEADS, w_ // N_HEADS).transpose(0, 2, 1, 3)


def from_heads(t):
    b_, h_, n_, d_ = t.shape
    return t.transpose(0, 2, 1, 3).reshape(b_, n_, h_ * d_)


def to_chunks(t):
    b_, h_, n_ = t.shape[:3]
    t = t.reshape(b_, h_, n_ // CHUNK, CHUNK, *t.shape[3:])
    return jnp.moveaxis(t, 2, 0)


def from_chunks(t):
    t = jnp.moveaxis(t, 0, 2)
    return t.reshape(t.shape[0], t.shape[1], t.shape[2] * t.shape[3], *t.shape[4:])


def flip(t):
    return t[:, :, ::-1]


def retention_scan(q, k, v, log_g, s0, strict, need_out):
    idx = jnp.arange(CHUNK, dtype=jnp.float32)
    lg = log_g[:, None]
    qc, kc, vc = to_chunks(q), to_chunks(k), to_chunks(v)
    k_dec = jnp.exp(lg * (CHUNK - 1 - idx))[..., None]
    kv = jnp.einsum('nbhjd,nbhje->nbhde', kc * k_dec, vc)
    chunk_dec = jnp.exp(log_g * CHUNK)[:, None, None]

    def step(s, kv_n):
        return chunk_dec * s + kv_n, s

    s_fin, s_prev = lax.scan(step, s0, kv)
    if not need_out:
        return None, s_fin
    diff = idx[:, None] - idx[None, :]
    mask = (diff > 0) if strict else (diff >= 0)
    dmat = jnp.where(mask, jnp.exp(lg[..., None] * jnp.where(mask, diff, 0.0)), 0.0)
    q_dec = jnp.exp(lg * (idx + 1))[..., None]
    scores = jnp.einsum('nbhid,nbhjd->nbhij', qc, kc) * dmat
    o = (jnp.einsum('nbhij,nbhjd->nbhid', scores, vc)
         + jnp.einsum('nbhid,nbhde->nbhie', qc * q_dec, s_prev))
    return from_chunks(o), s_fin


def retention_branch(pc, pl, ang_t, ret_logit, ctx_out):
    f32 = jnp.float32
    out_dtype = pl.dtype

    def prep(p, rot):
        q, k, v, g = jnp.split(p, 4, axis=-1)
        q, k, v = (to_heads(t).astype(f32) for t in (q, k, v))
        k = k * HEAD_DIM ** -0.5
        if rot:
            q, k = rotate(q, ang_t), rotate(k, ang_t)
        return q, k, v, g

    qc, kc, vc, gc = prep(pc, False)
    ql, kl, vl, gl = prep(pl, True)
    log_g = jax.nn.log_sigmoid(ret_logit.astype(f32))
    s0 = jnp.zeros(qc.shape[:2] + (HEAD_DIM, HEAD_DIM), f32)
    oc_f, sc_f = retention_scan(qc, kc, vc, log_g[0], s0, False, ctx_out)
    oc_b, sc_b = retention_scan(flip(qc), flip(kc), flip(vc), log_g[1], s0, True, ctx_out)
    ol_f, _ = retention_scan(ql, kl, vl, log_g[0], sc_f, False, True)
    ol_b, _ = retention_scan(flip(ql), flip(kl), flip(vl), log_g[1], sc_b, True, True)

    def finish(o, g):
        return from_heads(layernorm_noaffine(o)).astype(out_dtype) * jax.nn.silu(g)

    y_l = finish(ol_f + flip(ol_b), gl)
    y_c = finish(oc_f + flip(oc_b), gc) if ctx_out else None
    return y_l, y_c


def spatial_gating_branch(p, norm_g, w_s, b_s):
    z = jax.nn.gelu(p)
    u, v = z[..., :MIX_W], z[..., MIX_W:]
    v = layernorm_noaffine(v) * norm_g
    b_, n_, _ = v.shape
    v = v.reshape(b_, n_ // SG_CHUNK, SG_CHUNK, N_HEADS, HEAD_DIM)
    mixed = jnp.einsum('gij,bnjgd->bnigd', w_s, v) + b_s.T[:, :, None]
    return u * mixed.reshape(b_, n_, MIX_W)


def short_conv(x, w):
    pad = w.shape[0] // 2
    n_ = x.shape[1]
    xp = jnp.pad(x, ((0, 0), (pad, pad), (0, 0)))
    y = xp[:, 0:n_] * w[0]
    for i in range(1, w.shape[0]):
        y = y + xp[:, i:i + n_] * w[i]
    return y


def deltanet_scan(q, k, v, g, beta, s0, need_out):
    qc, kc, vc = to_chunks(q), to_chunks(k), to_chunks(v)
    gc, bc = to_chunks(g), to_chunks(beta)
    G = jnp.cumsum(gc, axis=-1)
    idx = jnp.arange(CHUNK)
    strict = idx[:, None] > idx[None, :]
    incl = idx[:, None] >= idx[None, :]
    gdiff = G[..., :, None] - G[..., None, :]
    kk = jnp.einsum('nbhid,nbhjd->nbhij', kc, kc)
    a_mat = jnp.where(strict, jnp.exp(jnp.where(strict, gdiff, 0.0)) * kk, 0.0) * bc[..., None]
    a_mat = a_mat + jnp.eye(CHUNK, dtype=a_mat.dtype)
    u = lax.linalg.triangular_solve(a_mat, vc * bc[..., None], left_side=True, lower=True, unit_diagonal=True)
    wk = lax.linalg.triangular_solve(a_mat, kc * (bc * jnp.exp(G))[..., None], left_side=True, lower=True, unit_diagonal=True)
    g_last = G[..., -1:]
    k_dec = kc * jnp.exp(g_last - G)[..., None]

    def step(s, inp):
        u_n, wk_n, kdec_n, glast_n = inp
        w = u_n - jnp.einsum('bhik,bhkv->bhiv', wk_n, s)
        s_new = jnp.exp(glast_n)[..., None] * s + jnp.einsum('bhik,bhiv->bhkv', kdec_n, w)
        return s_new, (w, s)

    s_fin, (w_all, s_prev) = lax.scan(step, s0, (u, wk, k_dec, g_last))
    if not need_out:
        return None, s_fin
    attn = jnp.where(incl, jnp.exp(jnp.where(incl, gdiff, 0.0)), 0.0) * jnp.einsum('nbhid,nbhjd->nbhij', qc, kc)
    o = (jnp.exp(G)[..., None] * jnp.einsum('nbhik,nbhkv->nbhiv', qc, s_prev)
         + jnp.einsum('nbhij,nbhjv->nbhiv', attn, w_all))
    return from_chunks(o), s_fin


def deltanet_branch(pc, pl, conv_w, A_log, dt_bias, norm_g, ctx_out):
    f32 = jnp.float32
    neg_a = -jnp.exp(A_log.astype(f32))
    dtb = dt_bias.astype(f32)

    def prep(p):
        b_, n_, _ = p.shape
        qkv = jax.nn.silu(short_conv(p[..., :3 * MIX_W], conv_w))
        q, k, v = jnp.split(qkv, 3, axis=-1)
        q = l2norm(to_heads(q)) * HEAD_DIM ** -0.5
        k = l2norm(to_heads(k))
        v = to_heads(v).astype(f32)
        a = p[..., 4 * MIX_W:4 * MIX_W + 2 * N_HEADS].astype(f32).reshape(b_, n_, 2, N_HEADS)
        b = p[..., 4 * MIX_W + 2 * N_HEADS:].astype(f32).reshape(b_, n_, 2, N_HEADS)
        g = jnp.moveaxis(neg_a * jax.nn.softplus(a + dtb), 1, -1)
        beta = jnp.moveaxis(jax.nn.sigmoid(b), 1, -1)
        return q, k, v, g, beta, p[..., 3 * MIX_W:4 * MIX_W]

    qc, kc, vc, gc, bc, zc = prep(pc)
    ql, kl, vl, gl, bl, zl = prep(pl)
    s0 = jnp.zeros(qc.shape[:2] + (HEAD_DIM, HEAD_DIM), f32)
    oc_f, sc_f = deltanet_scan(qc, kc, vc, gc[:, 0], bc[:, 0], s0, ctx_out)
    oc_b, sc_b = deltanet_scan(flip(qc), flip(kc), flip(vc), flip(gc[:, 1]), flip(bc[:, 1]), s0, ctx_out)
    ol_f, _ = deltanet_scan(ql, kl, vl, gl[:, 0], bl[:, 0], sc_f, True)
    ol_b, _ = deltanet_scan(flip(ql), flip(kl), flip(vl), flip(gl[:, 1]), flip(bl[:, 1]), sc_b, True)

    def finish(o, z):
        return from_heads(rmsnorm(o, norm_g)).astype(z.dtype) * jax.nn.silu(z)

    y_l = finish(ol_f + flip(ol_b), zl)
    y_c = finish(oc_f + flip(oc_b), zc) if ctx_out else None
    return y_l, y_c


def mla_branch(pc, pl, ang_row, ang_col, q_norm_g, kv_norm_g, w_uq, w_ukv, ctx_out):
    scale = (NOPE_DIM + ROPE_DIM) ** -0.5

    def keys_values(p, rot):
        ckv = rmsnorm(p[..., Q_LORA:Q_LORA + KV_LORA], kv_norm_g)
        kv = to_heads(ckv @ w_ukv)
        k_nope, v = kv[..., :NOPE_DIM], kv[..., NOPE_DIM:]
        kr = p[..., Q_LORA + KV_LORA:][:, None]
        if rot:
            kr = rotate_2d(kr, ang_row, ang_col)
        k = jnp.concatenate([k_nope, jnp.broadcast_to(kr, k_nope.shape[:3] + (ROPE_DIM,))], axis=-1)
        return k, v

    def queries(p, rot):
        cq = rmsnorm(p[..., :Q_LORA], q_norm_g)
        q = to_heads(cq @ w_uq)
        if rot:
            q = jnp.concatenate([q[..., :NOPE_DIM], rotate_2d(q[..., NOPE_DIM:], ang_row, ang_col)], axis=-1)
        return q

    def attend(q, k, v):
        s = jnp.einsum('bhqd,bhkd->bhqk', q, k).astype(jnp.float32) * scale
        pr = jax.nn.softmax(s, axis=-1).astype(v.dtype)
        return jnp.einsum('bhqk,bhkd->bhqd', pr, v)

    kc, vc = keys_values(pc, False)
    kl, vl = keys_values(pl, True)
    k_all = jnp.concatenate([kc, kl], axis=2)
    v_all = jnp.concatenate([vc, vl], axis=2)
    ql = queries(pl, True)
    b_, h_, n_, dq = ql.shape
    qb = jnp.moveaxis(ql.reshape(b_, h_, n_ // CHUNK, CHUNK, dq), 2, 0)
    ob = lax.map(lambda qblk: attend(qblk, k_all, v_all), qb)
    y_l = from_heads(jnp.moveaxis(ob, 0, 2).reshape(b_, h_, n_, V_DIM))
    y_c = from_heads(attend(queries(pc, False), kc, vc)) if ctx_out else None
    return y_l, y_c


def hybrid_mixer(pc, pl, ang_t, ang_row, ang_col, ret_logit, sg_norm_g, sg_w, sg_b,
                 dn_conv_w, dn_A_log, dn_dt_bias, dn_norm_g, mla_q_norm_g, mla_kv_norm_g,
                 mla_w_uq, mla_w_ukv, w_branch, w_out, ctx_out):
    def cols(p, a, b):
        return p[..., a:b]

    ret_l, ret_c = retention_branch(cols(pc, OFF_RET, OFF_SG), cols(pl, OFF_RET, OFF_SG), ang_t, ret_logit, ctx_out)
    sg_l = spatial_gating_branch(cols(pl, OFF_SG, OFF_DN), sg_norm_g, sg_w, sg_b)
    dn_l, dn_c = deltanet_branch(cols(pc, OFF_DN, OFF_MLA), cols(pl, OFF_DN, OFF_MLA),
                                 dn_conv_w, dn_A_log, dn_dt_bias, dn_norm_g, ctx_out)
    mla_l, mla_c = mla_branch(cols(pc, OFF_MLA, OFF_GATE), cols(pl, OFF_MLA, OFF_GATE), ang_row, ang_col,
                              mla_q_norm_g, mla_kv_norm_g, mla_w_uq, mla_w_ukv, ctx_out)

    def merge(p, ys):
        acc = None
        for i, y in enumerate(ys):
            gate = jax.nn.sigmoid(cols(p, OFF_GATE + i * D_MODEL, OFF_GATE + (i + 1) * D_MODEL))
            term = gate * (y @ w_branch[i])
            acc = term if acc is None else acc + term
        return acc @ w_out

    y_l = merge(pl, (ret_l, sg_l, dn_l, mla_l))
    if not ctx_out:
        return y_l, None
    sg_c = spatial_gating_branch(cols(pc, OFF_SG, OFF_DN), sg_norm_g, sg_w, sg_b)
    y_c = merge(pc, (ret_c, sg_c, dn_c, mla_c))
    return y_l, y_c


def swiglu(t, w1, w3, w2):
    return (jax.nn.silu(t @ w1) * (t @ w3)) @ w2


def moe_ffn(h, router_w, router_bias, w1, w3, w2, sw1, sw3, sw2):
    shp = h.shape
    t = h.reshape(-1, shp[-1])
    aff = jax.nn.sigmoid((t @ router_w).astype(jnp.float32))
    sel = aff + router_bias.astype(jnp.float32)
    grp_score = lax.top_k(sel.reshape(-1, N_GROUPS, EXPERTS_PER_GROUP), TOP_K)[0].sum(-1)
    best = jnp.argmax(grp_score, axis=-1)
    in_grp = (jnp.arange(N_EXPERTS) // EXPERTS_PER_GROUP)[None, :] == best[:, None]
    _, idx = lax.top_k(jnp.where(in_grp, sel, -jnp.inf), TOP_K)
    wts = jnp.take_along_axis(aff, idx, axis=-1)
    wts = wts / jnp.sum(wts, axis=-1, keepdims=True)
    comb = jnp.sum(jax.nn.one_hot(idx, N_EXPERTS, dtype=jnp.float32) * wts[..., None], axis=1).astype(t.dtype)
    out = swiglu(t, sw1, sw3, sw2)
    for e in range(N_EXPERTS):
        out = out + comb[:, e:e + 1] * swiglu(t, w1[e], w3[e], w2[e])
    return out.reshape(shp)


def setup_inputs(seed: int = 0) -> dict:
    key = jax.random.key(seed)
    ks = iter(jax.random.split(key, 48))
    f32 = jnp.float32

    def nrm(shape, scale):
        return jax.random.normal(next(ks), shape, f32) * scale

    def gain(shape):
        return 1.0 + 0.05 * jax.random.normal(next(ks), shape, f32)

    L, D = DEPTH, D_MODEL
    x = nrm((BATCH, SEQ, D), 1.0)
    c = nrm((BATCH, D), 1.0)
    ctx = nrm((BATCH, CTX_LEN, D), 1.0)
    c_ctx = nrm((D,), 1.0)
    w_ada = nrm((L, D, 6 * D), 0.5 * D ** -0.5)
    b_ada = nrm((L, 6 * D), 0.01)
    g_pre1 = gain((L, D))
    g_post1 = gain((L, D))
    g_pre2 = gain((L, D))
    g_post2 = gain((L, D))
    w_in = nrm((L, D, IN_COLS), D ** -0.5)
    heads = jnp.arange(N_HEADS, dtype=f32)
    ret_decay_logit = jnp.log(2.0 ** (RET_DECAY_EXP0 + heads) - 1.0) + nrm((L, 2, N_HEADS), 0.05)
    sg_norm_g = gain((L, MIX_W))
    sg_w = nrm((L, N_HEADS, SG_CHUNK, SG_CHUNK), 0.5 * SG_CHUNK ** -0.5)
    sg_b = 1.0 + nrm((L, N_HEADS, SG_CHUNK), 0.02)
    dn_conv_w = nrm((L, CONV_W, 3 * MIX_W), CONV_W ** -0.5)
    dn_A_log = jnp.log(jax.random.uniform(next(ks), (L, 2, N_HEADS), f32, 1.0, 16.0))
    dt = jnp.exp(jax.random.uniform(next(ks), (L, 2, N_HEADS), f32, math.log(1e-3), math.log(1e-1)))
    dn_dt_bias = dt + jnp.log(-jnp.expm1(-dt))
    dn_norm_g = gain((L, HEAD_DIM))
    mla_q_norm_g = gain((L, Q_LORA))
    mla_kv_norm_g = gain((L, KV_LORA))
    mla_w_uq = nrm((L, Q_LORA, N_HEADS * (NOPE_DIM + ROPE_DIM)), Q_LORA ** -0.5)
    mla_w_ukv = nrm((L, KV_LORA, N_HEADS * (NOPE_DIM + V_DIM)), KV_LORA ** -0.5)
    w_branch = nrm((L, N_BRANCH, MIX_W, D), MIX_W ** -0.5)
    w_out = nrm((L, D, D), D ** -0.5)
    router_w = nrm((D, N_EXPERTS), D ** -0.5)
    router_bias = nrm((N_EXPERTS,), 0.01)
    moe_w1 = nrm((L, N_EXPERTS, D, D_EXPERT), D ** -0.5)
    moe_w3 = nrm((L, N_EXPERTS, D, D_EXPERT), D ** -0.5)
    moe_w2 = nrm((L, N_EXPERTS, D_EXPERT, D), D_EXPERT ** -0.5)
    shared_w1 = nrm((L, D, D_EXPERT), D ** -0.5)
    shared_w3 = nrm((L, D, D_EXPERT), D ** -0.5)
    shared_w2 = nrm((L, D_EXPERT, D), D_EXPERT ** -0.5)
    return {"x": x, "c": c, "ctx": ctx, "c_ctx": c_ctx, "w_ada": w_ada, "b_ada": b_ada,
            "g_pre1": g_pre1, "g_post1": g_post1, "g_pre2": g_pre2, "g_post2": g_post2,
            "w_in": w_in, "ret_decay_logit": ret_decay_logit, "sg_norm_g": sg_norm_g, "sg_w": sg_w,
            "sg_b": sg_b, "dn_conv_w": dn_conv_w, "dn_A_log": dn_A_log, "dn_dt_bias": dn_dt_bias,
            "dn_norm_g": dn_norm_g, "mla_q_norm_g": mla_q_norm_g, "mla_kv_norm_g": mla_kv_norm_g,
            "mla_w_uq": mla_w_uq, "mla_w_ukv": mla_w_ukv, "w_branch": w_branch, "w_out": w_out,
            "router_w": router_w, "router_bias": router_bias, "moe_w1": moe_w1, "moe_w3": moe_w3,
            "moe_w2": moe_w2, "shared_w1": shared_w1, "shared_w3": shared_w3, "shared_w2": shared_w2}


def reference(x, c, ctx, c_ctx, w_ada, b_ada, g_pre1, g_post1, g_pre2, g_post2, w_in,
              ret_decay_logit, sg_norm_g, sg_w, sg_b, dn_conv_w, dn_A_log, dn_dt_bias, dn_norm_g,
              mla_q_norm_g, mla_kv_norm_g, mla_w_uq, mla_w_ukv, w_branch, w_out,
              router_w, router_bias, moe_w1, moe_w3, moe_w2, shared_w1, shared_w3, shared_w2):
    n_lat = x.shape[1]
    rows = n_lat // GRID_W
    t_pos = jnp.arange(n_lat)
    row = jnp.repeat(jnp.arange(rows), GRID_W)
    col = jnp.tile(jnp.arange(GRID_W), rows)
    ang_t = rope_angles(t_pos, HEAD_DIM)
    ang_row = rope_angles(row, ROPE_DIM // 2)
    ang_col = rope_angles(col, ROPE_DIM // 2)

    xl, xc = x, ctx
    for l in range(DEPTH):
        last = l == DEPTH - 1
        ml = adaln(c, w_ada[l], b_ada[l])
        mc = adaln(c_ctx[None], w_ada[l], b_ada[l])
        pl = modulate(rmsnorm(xl, g_pre1[l]), ml[0], ml[1]) @ w_in[l]
        pc = modulate(rmsnorm(xc, g_pre1[l]), mc[0], mc[1]) @ w_in[l]
        yl, yc = hybrid_mixer(pc, pl, ang_t, ang_row, ang_col, ret_decay_logit[l], sg_norm_g[l], sg_w[l], sg_b[l],
                              dn_conv_w[l], dn_A_log[l], dn_dt_bias[l], dn_norm_g[l], mla_q_norm_g[l],
                              mla_kv_norm_g[l], mla_w_uq[l], mla_w_ukv[l], w_branch[l], w_out[l], not last)
        xl = xl + ml[2] * rmsnorm(yl, g_post1[l])
        hl = modulate(rmsnorm(xl, g_pre2[l]), ml[3], ml[4])
        xl = xl + ml[5] * rmsnorm(moe_ffn(hl, router_w, router_bias, moe_w1[l], moe_w3[l], moe_w2[l],
                                          shared_w1[l], shared_w3[l], shared_w2[l]), g_post2[l])
        if not last:
            xc = xc + mc[2] * rmsnorm(yc, g_post1[l])
            hc = modulate(rmsnorm(xc, g_pre2[l]), mc[3], mc[4])
            xc = xc + mc[5] * rmsnorm(moe_ffn(hc, router_w, router_bias, moe_w1[l], moe_w3[l], moe_w2[l],
                                              shared_w1[l], shared_w3[l], shared_w2[l]), g_post2[l])
    return xl
```

```cpp
#include <hip/hip_runtime.h>
#include <stdint.h>
#include <stdio.h>

#ifndef MK_ONE_LAUNCH
#define MK_ONE_LAUNCH 0
#endif

typedef unsigned short bf16_t;
typedef short bf16x8 __attribute__((ext_vector_type(8)));
typedef short s16x4 __attribute__((ext_vector_type(4)));
typedef float f32x4 __attribute__((ext_vector_type(4)));
typedef float f32x16 __attribute__((ext_vector_type(16)));
typedef unsigned u32x4 __attribute__((ext_vector_type(4)));
typedef unsigned u32x2 __attribute__((ext_vector_type(2)));
#define DI __device__ __forceinline__

constexpr int NB = 4, SEQ = 8192, CTXL = 256, SU = SEQ + CTXL, NT = NB * SU, DM = 1024;
constexpr int PW = 2992, INC = 7088;
constexpr int OFF_SG = 1024, OFF_DN = 1536, OFF_MLA = 2576, OFF_GATE = 2992;
constexpr int NCHUNK = SU / 128;
constexpr int NMT = NT / 128;
constexpr float EPS = 1e-6f;
constexpr int NTHR = 256;

struct Params {
    const float *x, *c, *ctx, *c_ctx, *w_ada, *b_ada, *g_pre1, *g_post1, *g_pre2, *g_post2, *w_in, *ret_logit, *sg_norm_g, *sg_w, *sg_b,
        *dn_conv_w, *dn_A_log, *dn_dt_bias, *dn_norm_g, *mla_q_norm_g, *mla_kv_norm_g, *mla_w_uq, *mla_w_ukv, *w_branch, *w_out,
        *router_w, *router_bias, *moe_w1, *moe_w3, *moe_w2, *sh_w1, *sh_w3, *sh_w2;
    float* out;
    unsigned* bar; int* cnt; float* mod; float* xc;
    bf16_t *WinT, *WbrT, *WoutT, *W1T, *W3T, *W2T, *WuqT, *WukvT;
    bf16_t *H, *P, *DNQKV, *Y, *MQ, *MK, *MVT;
    float *DG, *DB, *ewt;
    int* elist;
};

DI float bf2f(bf16_t v) { return __uint_as_float((unsigned)v << 16); }
DI bf16_t f2bf(float f) { unsigned u = __float_as_uint(f); u += 0x7fffu + ((u >> 16) & 1u); return (bf16_t)(u >> 16); }
DI unsigned pack2(float lo, float hi) { return (unsigned)f2bf(lo) | ((unsigned)f2bf(hi) << 16); }
DI float wave_sum(float v) {
#pragma unroll
    for (int o = 32; o > 0; o >>= 1) v += __shfl_xor(v, o, 64);
    return v;
}
DI float siluf(float x) { return x / (1.f + __expf(-x)); }
DI float sigmoidf_(float x) { return 1.f / (1.f + __expf(-x)); }
DI float gelu_tanh(float x) { const float u = 0.7978845608028654f * (x + 0.044715f * x * x * x); return 0.5f * x * (1.f + tanhf(u)); }
DI float softplusf_(float x) { return x > 20.f ? x : log1pf(expf(x)); }
DI int tok_b(int tok) { return tok / SU; }
DI int tok_s(int tok) { return tok % SU; }
DI void block_sum4(float& a, float& b, float& c, float& d, float* red) {
    a = wave_sum(a); b = wave_sum(b); c = wave_sum(c); d = wave_sum(d);
    const int w = threadIdx.x >> 6, lane = threadIdx.x & 63;
    __syncthreads();
    if (lane == 0) { red[w * 4 + 0] = a; red[w * 4 + 1] = b; red[w * 4 + 2] = c; red[w * 4 + 3] = d; }
    __syncthreads();
    a = red[0] + red[4] + red[8] + red[12]; b = red[1] + red[5] + red[9] + red[13];
    c = red[2] + red[6] + red[10] + red[14]; d = red[3] + red[7] + red[11] + red[15];
}

template <int NF, class ARowF>
DI void gemm_tile(f32x4 (&acc)[4][NF], ARowF arow, const bf16_t* __restrict__ Bt, int ldb, int K, char* smem) {
    const int t = threadIdx.x, lane = t & 63, wave = t >> 6, wr = wave >> 1, wc = wave & 1, fr = lane & 15, fq = lane >> 4;
    const int lc = t & 7, lr = t >> 3;
    char* sA = smem; char* sB = smem + 16384;
    const bf16_t* ap[4]; const bf16_t* bp[NF];
#pragma unroll
    for (int i = 0; i < 4; ++i) ap[i] = arow(lr + 32 * i) + lc * 8;
#pragma unroll
    for (int i = 0; i < NF; ++i) bp[i] = Bt + (size_t)(lr + 32 * i) * ldb + lc * 8;
    u32x4 ra[4], rb[NF];
#pragma unroll
    for (int i = 0; i < 4; ++i) ra[i] = *(const u32x4*)(ap[i]);
#pragma unroll
    for (int i = 0; i < NF; ++i) rb[i] = *(const u32x4*)(bp[i]);
    const int woff = lr * 128 + ((lc ^ (lr & 7)) * 16);
    for (int k0 = 0; k0 < K; k0 += 64) {
        __syncthreads();
#pragma unroll
        for (int i = 0; i < 4; ++i) *(u32x4*)(sA + woff + i * 4096) = ra[i];
#pragma unroll
        for (int i = 0; i < NF; ++i) *(u32x4*)(sB + woff + i * 4096) = rb[i];
        __syncthreads();
        if (k0 + 64 < K) {
#pragma unroll
            for (int i = 0; i < 4; ++i) ra[i] = *(const u32x4*)(ap[i] + k0 + 64);
#pragma unroll
            for (int i = 0; i < NF; ++i) rb[i] = *(const u32x4*)(bp[i] + k0 + 64);
        }
#pragma unroll
        for (int kk = 0; kk < 2; ++kk) {
            bf16x8 af[4], bfr[NF];
#pragma unroll
            for (int m = 0; m < 4; ++m) { const int row = wr * 64 + m * 16 + fr; af[m] = *(const bf16x8*)(sA + row * 128 + (((kk * 4 + fq) ^ (row & 7)) * 16)); }
#pragma unroll
            for (int n = 0; n < NF; ++n) { const int row = wc * 16 * NF + n * 16 + fr; bfr[n] = *(const bf16x8*)(sB + row * 128 + (((kk * 4 + fq) ^ (row & 7)) * 16)); }
#pragma unroll
            for (int m = 0; m < 4; ++m)
#pragma unroll
                for (int n = 0; n < NF; ++n) acc[m][n] = __builtin_amdgcn_mfma_f32_16x16x32_bf16(bfr[n], af[m], acc[m][n], 0, 0, 0);
        }
    }
}
template <int NF>
DI void zero_acc(f32x4 (&acc)[4][NF]) {
#pragma unroll
    for (int m = 0; m < 4; ++m)
#pragma unroll
        for (int n = 0; n < NF; ++n) acc[m][n] = (f32x4){0.f, 0.f, 0.f, 0.f};
}
template <int NF, class F>
DI void for_frags(const f32x4 (&acc)[4][NF], F f) {
    const int t = threadIdx.x, lane = t & 63, wave = t >> 6, wr = wave >> 1, wc = wave & 1, fr = lane & 15, fq = lane >> 4;
#pragma unroll
    for (int m = 0; m < 4; ++m)
#pragma unroll
        for (int n = 0; n < NF; ++n) f(wr * 64 + m * 16 + fr, wc * 16 * NF + n * 16 + fq * 4, acc[m][n]);
}
DI void store_bf4(bf16_t* dst, f32x4 v) { u32x2 o; o[0] = pack2(v[0], v[1]); o[1] = pack2(v[2], v[3]); *(u32x2*)dst = o; }

struct TJob { const float* src; bf16_t* dst; int K, N; };
constexpr int NJOBS = 59;
DI TJob get_job(const Params& p, int l, int j) {
    TJob r;
    if (j == 0) { r.src = p.w_in + (size_t)l * DM * INC; r.dst = p.WinT; r.K = DM; r.N = INC; }
    else if (j < 5) { const int i = j - 1; r.src = p.w_branch + ((size_t)l * 4 + i) * 256 * DM; r.dst = p.WbrT + (size_t)i * DM * 256; r.K = 256; r.N = DM; }
    else if (j == 5) { r.src = p.w_out + (size_t)l * DM * DM; r.dst = p.WoutT; r.K = DM; r.N = DM; }
    else if (j < 23) { const int e = j - 6; r.src = e < 16 ? p.moe_w1 + ((size_t)l * 16 + e) * DM * 256 : p.sh_w1 + (size_t)l * DM * 256; r.dst = p.W1T + (size_t)e * 256 * DM; r.K = DM; r.N = 256; }
    else if (j < 40) { const int e = j - 23; r.src = e < 16 ? p.moe_w3 + ((size_t)l * 16 + e) * DM * 256 : p.sh_w3 + (size_t)l * DM * 256; r.dst = p.W3T + (size_t)e * 256 * DM; r.K = DM; r.N = 256; }
    else if (j < 57) { const int e = j - 40; r.src = e < 16 ? p.moe_w2 + ((size_t)l * 16 + e) * 256 * DM : p.sh_w2 + (size_t)l * 256 * DM; r.dst = p.W2T + (size_t)e * DM * 256; r.K = 256; r.N = DM; }
    else if (j == 57) { r.src = p.mla_w_uq + (size_t)l * 256 * 384; r.dst = p.WuqT; r.K = 256; r.N = 384; }
    else { r.src = p.mla_w_ukv + (size_t)l * 128 * 512; r.dst = p.WukvT; r.K = 128; r.N = 512; }
    return r;
}
DI void ph_convert(const Params& p, int l, char* smem) {
    float* tile = (float*)smem;
    const int t = threadIdx.x, G = gridDim.x;
    int base = 0;
    for (int j = 0; j < NJOBS; ++j) {
        const TJob jb = get_job(p, l, j);
        const int tn = (jb.N + 63) / 64, nt = (jb.K / 64) * tn;
        const int first = (int)(((long)blockIdx.x - base) % G + G) % G;
        for (int ti = first; ti < nt; ti += G) {
            const int k0 = (ti / tn) * 64, n0 = (ti % tn) * 64;
            __syncthreads();
#pragma unroll
            for (int i = 0; i < 16; ++i) { const int kr = (t >> 6) + 4 * i, nc = t & 63; tile[kr * 65 + nc] = (n0 + nc < jb.N) ? jb.src[(size_t)(k0 + kr) * jb.N + n0 + nc] : 0.f; }
            __syncthreads();
#pragma unroll
            for (int i = 0; i < 8; ++i) { const int nr = (t >> 5) + 8 * i, kc = (t & 31) * 2;
                if (n0 + nr < jb.N) *(unsigned*)(jb.dst + (size_t)(n0 + nr) * jb.K + k0 + kc) = pack2(tile[kc * 65 + nr], tile[(kc + 1) * 65 + nr]); }
        }
        base += nt;
    }
}

DI void ph_adaln(const Params& p, char* smem) {
    float* sc = (float*)smem;
    float* red = sc + 5 * DM;
    const int t = threadIdx.x;
    for (int i = t; i < 5 * DM; i += NTHR) { const int r = i / DM, k = i % DM; const float v = r < 4 ? p.c[r * DM + k] : p.c_ctx[k]; sc[i] = siluf(v); }
    __syncthreads();
    for (int u = blockIdx.x; u < 2 * 96; u += gridDim.x) {
        const int l = u / 96, cg = u % 96, col = cg * 64 + (t & 63), kg = t >> 6;
        float a[5] = {0.f, 0.f, 0.f, 0.f, 0.f};
        const float* w = p.w_ada + (size_t)l * DM * 6 * DM + col;
        for (int k = kg * 256; k < kg * 256 + 256; ++k) { const float wv = w[(size_t)k * 6 * DM];
#pragma unroll
            for (int r = 0; r < 5; ++r) a[r] += sc[r * DM + k] * wv; }
        __syncthreads();
#pragma unroll
        for (int r = 0; r < 5; ++r) red[(kg * 5 + r) * 64 + (t & 63)] = a[r];
        __syncthreads();
        if (kg == 0) {
#pragma unroll
            for (int r = 0; r < 5; ++r) { const float s = red[(0 * 5 + r) * 64 + t] + red[(1 * 5 + r) * 64 + t] + red[(2 * 5 + r) * 64 + t] + red[(3 * 5 + r) * 64 + t];
                p.mod[((size_t)l * 5 + r) * 6 * DM + col] = s + p.b_ada[(size_t)l * 6 * DM + col]; }
        }
    }
}

DI const float* xrow_src(const Params& p, int l, int tok) {
    const int b = tok_b(tok), s = tok_s(tok);
    if (s < CTXL) return (l == 0 ? p.ctx : p.xc) + ((size_t)b * CTXL + s) * DM;
    return (l == 0 ? p.x : p.out) + ((size_t)b * SEQ + (s - CTXL)) * DM;
}
DI float* xrow_dst(const Params& p, int tok) {
    const int b = tok_b(tok), s = tok_s(tok);
    if (s < CTXL) return p.xc + ((size_t)b * CTXL + s) * DM;
    return p.out + ((size_t)b * SEQ + (s - CTXL)) * DM;
}
DI const float* mod_row(const Params& p, int l, int tok, int i) { const int b = tok_b(tok), s = tok_s(tok); const int r = s < CTXL ? 4 : b; return p.mod + (((size_t)l * 5 + r) * 6 + i) * DM; }

DI void ph_norm1(const Params& p, int l) {
    const int lane = threadIdx.x & 63, gw = blockIdx.x * 4 + (threadIdx.x >> 6), nw = gridDim.x * 4;
    if (blockIdx.x == 0 && threadIdx.x < 32) p.cnt[threadIdx.x] = 0;
    for (int tok = gw; tok < NT; tok += nw) {
        const float* src = xrow_src(p, l, tok);
        const float* sh = mod_row(p, l, tok, 0); const float* scl = mod_row(p, l, tok, 1); const float* g = p.g_pre1 + (size_t)l * DM;
        f32x4 v[4]; float ss = 0.f;
#pragma unroll
        for (int i = 0; i < 4; ++i) { v[i] = *(const f32x4*)(src + lane * 4 + 256 * i); ss += v[i][0] * v[i][0] + v[i][1] * v[i][1] + v[i][2] * v[i][2] + v[i][3] * v[i][3]; }
        ss = wave_sum(ss); const float rstd = rsqrtf(ss * (1.f / DM) + EPS);
#pragma unroll
        for (int i = 0; i < 4; ++i) { const int d = lane * 4 + 256 * i; const f32x4 gg = *(const f32x4*)(g + d), s1 = *(const f32x4*)(scl + d), s0 = *(const f32x4*)(sh + d);
            f32x4 o;
#pragma unroll
            for (int j = 0; j < 4; ++j) o[j] = v[i][j] * rstd * gg[j] * (1.f + s1[j]) + s0[j];
            store_bf4(p.H + (size_t)tok * DM + d, o); }
    }
}

DI void ph_inproj(const Params& p, char* smem) {
    for (int u = blockIdx.x; u < NMT * 24; u += gridDim.x) {
        const int mt = u / 24, nt = u % 24;
        f32x4 acc[4][4]; zero_acc(acc);
        const bf16_t* A = p.H + (size_t)mt * 128 * DM;
        gemm_tile(acc, [&](int r) { return A + (size_t)r * DM; }, p.WinT + (size_t)nt * 128 * DM, DM, DM, smem);
        bf16_t* out = p.P + (size_t)mt * 128 * PW + nt * 128;
        for_frags(acc, [&](int r, int c, f32x4 v) { if (nt * 128 + c < PW) store_bf4(out + (size_t)r * PW + c, v); });
    }
}

DI void ph_prep(const Params& p, int l, char* smem) {
    float* red = (float*)smem;
    const int t = threadIdx.x, lane = t & 63;
    for (int tok = blockIdx.x; tok < NT; tok += gridDim.x) {
        const int b = tok_b(tok), s = tok_s(tok); const bool isctx = s < CTXL; const int n = s - CTXL;
        bf16_t* pr = p.P + (size_t)tok * PW;
        {
            const int which = t >> 7, hh = (t >> 5) & 3, d = t & 31;
            bf16_t* q = pr + which * 256 + hh * 64;
            const float x1 = bf2f(q[d]), x2 = bf2f(q[d + 32]); float y1 = x1, y2 = x2;
            if (!isctx) { const float inv = exp2f(-(float)d * (13.287712379549449f / 32.f)); float sn, cs; sincosf((float)n * inv, &sn, &cs); y1 = x1 * cs - x2 * sn; y2 = x2 * cs + x1 * sn; }
            const float scq = which ? 0.125f : 1.f;
            q[d] = f2bf(y1 * scq); q[d + 32] = f2bf(y2 * scq);
        }
        const float su = gelu_tanh(bf2f(pr[OFF_SG + t])), sv = gelu_tanh(bf2f(pr[OFF_SG + 256 + t]));
        const float cq = bf2f(pr[OFF_MLA + t]), ckv = t < 128 ? bf2f(pr[OFF_MLA + 256 + t]) : 0.f;
        float s0 = sv, s1 = cq * cq, s2 = ckv * ckv, s3 = 0.f;
        block_sum4(s0, s1, s2, s3, red);
        const float mean = s0 * (1.f / 256.f), dv = sv - mean;
        float v0 = dv * dv, v1 = 0.f, v2 = 0.f, v3 = 0.f;
        block_sum4(v0, v1, v2, v3, red);
        pr[OFF_SG + t] = f2bf(su);
        pr[OFF_SG + 256 + t] = f2bf(dv * rsqrtf(v0 * (1.f / 256.f) + EPS) * p.sg_norm_g[l * 256 + t]);
        pr[OFF_MLA + t] = f2bf(cq * rsqrtf(s1 * (1.f / 256.f) + EPS) * p.mla_q_norm_g[l * 256 + t]);
        if (t < 128) pr[OFF_MLA + 256 + t] = f2bf(ckv * rsqrtf(s2 * (1.f / 128.f) + EPS) * p.mla_kv_norm_g[l * 128 + t]);
        if (t < 16) {
            const int part = t >> 3, i = t & 7;
            const float x1 = bf2f(pr[OFF_MLA + 384 + part * 16 + i]), x2 = bf2f(pr[OFF_MLA + 384 + part * 16 + i + 8]); float y1 = x1, y2 = x2;
            if (!isctx) { const float pos = (float)(part == 0 ? (n >> 6) : (n & 63)); const float inv = exp2f(-(float)i * (13.287712379549449f / 8.f)); float sn, cs; sincosf(pos * inv, &sn, &cs);
                y1 = x1 * cs - x2 * sn; y2 = x2 * cs + x1 * sn; }
#pragma unroll
            for (int hh = 0; hh < 4; ++hh) { bf16_t* kd = p.MK + (((size_t)b * 4 + hh) * SU + s) * 96 + 64 + part * 16 + i; kd[0] = f2bf(y1); kd[8] = f2bf(y2); }
        }
        {
            const int pos = isctx ? s : n, len = isctx ? CTXL : SEQ;
#pragma unroll
            for (int j = 0; j < 3; ++j) {
                const int c = t + 256 * j; float a = 0.f;
#pragma unroll
                for (int i = 0; i < 5; ++i) { const int ps = pos + i - 2; if (ps >= 0 && ps < len) a += bf2f(p.P[(size_t)(tok + i - 2) * PW + OFF_DN + c]) * p.dn_conv_w[((size_t)l * 5 + i) * 768 + c]; }
                float y = siluf(a);
                if (j < 2) { const float ssq = wave_sum(y * y); y *= rsqrtf(ssq + EPS) * (j == 0 ? 0.125f : 1.f); }
                p.DNQKV[(size_t)tok * 768 + c] = f2bf(y);
            }
            if (t < 8) { const float a = bf2f(pr[OFF_DN + 1024 + t]); p.DG[(size_t)tok * 8 + t] = -expf(p.dn_A_log[l * 8 + t]) * softplusf_(a + p.dn_dt_bias[l * 8 + t]); }
            else if (t < 16) { p.DB[(size_t)tok * 8 + (t - 8)] = sigmoidf_(bf2f(pr[OFF_DN + 1024 + t])); }
        }
        (void)lane;
    }
}

DI void ph_mla_up(const Params& p, int bid, int nb, char* smem) {
    const float qscale = 0.10206207261596575f * 1.4426950408889634f;
    for (int u = bid; u < NMT * 7; u += nb) {
        const int mt = u / 7, j = u % 7;
        f32x4 acc[4][4]; zero_acc(acc);
        if (j < 3) {
            const bf16_t* A = p.P + (size_t)mt * 128 * PW + OFF_MLA;
            gemm_tile(acc, [&](int r) { return A + (size_t)r * PW; }, p.WuqT + (size_t)j * 128 * 256, 256, 256, smem);
            for_frags(acc, [&](int r, int c, f32x4 v) { const int tok = mt * 128 + r, col = j * 128 + c, hh = col / 96, d = col % 96;
                store_bf4(p.MQ + (((size_t)tok_b(tok) * 4 + hh) * SU + tok_s(tok)) * 96 + d, v * qscale); });
        } else {
            const int hh = j - 3;
            const bf16_t* A = p.P + (size_t)mt * 128 * PW + OFF_MLA + 256;
            gemm_tile(acc, [&](int r) { return A + (size_t)r * PW; }, p.WukvT + (size_t)hh * 128 * 128, 128, 128, smem);
            for_frags(acc, [&](int r, int c, f32x4 v) { const int tok = mt * 128 + r, b = tok_b(tok), s = tok_s(tok);
                if (c < 64) store_bf4(p.MK + (((size_t)b * 4 + hh) * SU + s) * 96 + c, v);
                else { bf16_t* d = p.MVT + (((size_t)b * 4 + hh) * 64 + (c - 64)) * SU + s; d[0] = f2bf(v[0]); d[SU] = f2bf(v[1]); d[2 * SU] = f2bf(v[2]); d[3 * SU] = f2bf(v[3]); } });
        }
    }
}

DI float rdl(float v, int i) { return __int_as_float(__builtin_amdgcn_readlane(__float_as_int(v), i)); }
DI void ph_scan(const Params& p, int l) {
    const int lane = threadIdx.x & 63, cid = blockIdx.x * 4 + (threadIdx.x >> 6);
    if (cid >= 64) return;
    const int kind = cid >> 5, b = (cid >> 3) & 3, hh = (cid >> 1) & 3, dir = cid & 1;
    float S[64];
#pragma unroll
    for (int i = 0; i < 64; ++i) S[i] = 0.f;
    const float gam = kind == 0 ? sigmoidf_(p.ret_logit[l * 8 + dir * 4 + hh]) : 0.f;
    for (int i = 0; i < SU; ++i) {
        const int s = dir == 0 ? i : (i < CTXL ? CTXL - 1 - i : SU - 1 - (i - CTXL));
        const size_t tok = (size_t)b * SU + s;
        float q, k, v, o = 0.f;
        if (kind == 0) {
            const bf16_t* pr = p.P + tok * PW + hh * 64 + lane;
            q = bf2f(pr[0]); k = bf2f(pr[256]); v = bf2f(pr[512]);
            if (dir == 0) {
#pragma unroll
                for (int d = 0; d < 64; ++d) { S[d] = gam * S[d] + rdl(k, d) * v; o += rdl(q, d) * S[d]; }
            } else {
#pragma unroll
                for (int d = 0; d < 64; ++d) { S[d] = gam * S[d]; o += rdl(q, d) * S[d]; S[d] += rdl(k, d) * v; }
            }
            p.Y[tok * DM + dir * 256 + hh * 64 + lane] = f2bf(o);
        } else {
            const bf16_t* pr = p.DNQKV + tok * 768 + hh * 64 + lane;
            q = bf2f(pr[0]); k = bf2f(pr[256]); v = bf2f(pr[512]);
            const float g = p.DG[tok * 8 + dir * 4 + hh], beta = p.DB[tok * 8 + dir * 4 + hh], eg = __expf(g);
            float kS = 0.f;
#pragma unroll
            for (int d = 0; d < 64; ++d) kS += rdl(k, d) * S[d];
            const float dd = beta * (v - eg * kS);
#pragma unroll
            for (int d = 0; d < 64; ++d) { S[d] = eg * S[d] + rdl(k, d) * dd; o += rdl(q, d) * S[d]; }
            p.Y[tok * DM + 512 + dir * 256 + hh * 64 + lane] = f2bf(o);
        }
    }
}

DI void ph_fin(const Params& p, int l) {
    const int lane = threadIdx.x & 63, gw = blockIdx.x * 4 + (threadIdx.x >> 6), nw = gridDim.x * 4;
    for (int tok = gw; tok < NT; tok += nw) {
        const int b = tok_b(tok), s = tok_s(tok);
        bf16_t* y = p.Y + (size_t)tok * DM; const bf16_t* pr = p.P + (size_t)tok * PW;
#pragma unroll
        for (int hh = 0; hh < 4; ++hh) {
            const int c = hh * 64 + lane;
            { const float o = bf2f(y[c]) + bf2f(y[256 + c]); const float mean = wave_sum(o) * (1.f / 64.f), d = o - mean; const float var = wave_sum(d * d) * (1.f / 64.f);
              const float r = d * rsqrtf(var + EPS) * siluf(bf2f(pr[768 + c]));
              const float o2 = bf2f(y[512 + c]) + bf2f(y[768 + c]); const float ms = wave_sum(o2 * o2) * (1.f / 64.f);
              const float r2 = o2 * rsqrtf(ms + EPS) * p.dn_norm_g[l * 64 + lane] * siluf(bf2f(pr[OFF_DN + 768 + c]));
              y[c] = f2bf(r); y[512 + c] = f2bf(r2); }
            if (s >= CTXL && lane < 16) {
                const int n = s - CTXL, part = lane >> 3, i = lane & 7;
                bf16_t* q = p.MQ + (((size_t)b * 4 + hh) * SU + s) * 96 + 64 + part * 16 + i;
                const float x1 = bf2f(q[0]), x2 = bf2f(q[8]); const float pos = (float)(part == 0 ? (n >> 6) : (n & 63)); const float inv = exp2f(-(float)i * (13.287712379549449f / 8.f));
                float sn, cs; sincosf(pos * inv, &sn, &cs); q[0] = f2bf(x1 * cs - x2 * sn); q[8] = f2bf(x2 * cs + x1 * sn);
            }
        }
    }
}

DI void sgm_unit(const Params& p, int l, int b, int c, int g, char* smem) {
    float* vt = (float*)smem;
    const int t = threadIdx.x; const size_t tok0 = (size_t)b * SU + c * 128;
    __syncthreads();
    for (int i = t; i < 128 * 64; i += NTHR) { const int j = i >> 6, d = i & 63; vt[i] = bf2f(p.P[(tok0 + j) * PW + OFF_SG + 256 + g * 64 + d]); }
    __syncthreads();
    const int d = t & 63, ig = __builtin_amdgcn_readfirstlane(t >> 6);
    for (int ii = 0; ii < 32; ++ii) {
        const int i = ig * 32 + ii;
        const float* w = p.sg_w + (((size_t)l * 4 + g) * 128 + i) * 128;
        float a = 0.f;
#pragma unroll 8
        for (int j = 0; j < 128; ++j) a += w[j] * vt[j * 64 + d];
        a += p.sg_b[((size_t)l * 4 + g) * 128 + i];
        const float u = bf2f(p.P[(tok0 + i) * PW + OFF_SG + g * 64 + d]);
        p.Y[(tok0 + i) * DM + 256 + g * 64 + d] = f2bf(u * a);
    }
}

DI int crow(int reg, int h) { return (reg & 3) + 8 * (reg >> 2) + 4 * h; }
DI bf16x8 pack8(const f32x16& x, int s) {
    u32x4 r; r[0] = pack2(x[8 * s + 0], x[8 * s + 1]); r[1] = pack2(x[8 * s + 2], x[8 * s + 3]); r[2] = pack2(x[8 * s + 4], x[8 * s + 5]); r[3] = pack2(x[8 * s + 6], x[8 * s + 7]);
    return __builtin_bit_cast(bf16x8, r);
}
DI void attn_unit(const Params& p, int b, int hh, int s0, int nkeys, char* smem) {
    char* sK = smem;
    char* sV = smem + 64 * 208;
    const int t = threadIdx.x, lane = t & 63, w = t >> 6, r = lane & 31, h2 = lane >> 5;
    const bf16_t* Kb = p.MK + ((size_t)b * 4 + hh) * SU * 96;
    const bf16_t* Vb = p.MVT + ((size_t)b * 4 + hh) * 64 * SU;
    const int sq = s0 + w * 32 + r;
    bf16x8 Qf[6];
    { const bf16_t* q = p.MQ + (((size_t)b * 4 + hh) * SU + sq) * 96 + 8 * h2;
#pragma unroll
      for (int st = 0; st < 6; ++st) Qf[st] = *(const bf16x8*)(q + 16 * st); }
    f32x16 O0, O1;
#pragma unroll
    for (int i = 0; i < 16; ++i) { O0[i] = 0.f; O1[i] = 0.f; }
    float mrun = -1e30f, lsum = 0.f;
    u32x4 rk[3], rv[2];
    auto gload = [&](int kt) {
#pragma unroll
        for (int i = 0; i < 3; ++i) { const int c = t + 256 * i, key = c / 12, part = c % 12; rk[i] = *(const u32x4*)(Kb + (size_t)(kt * 64 + key) * 96 + part * 8); }
#pragma unroll
        for (int i = 0; i < 2; ++i) { const int c = t + 256 * i, row = c >> 3, part = c & 7; rv[i] = *(const u32x4*)(Vb + (size_t)row * SU + kt * 64 + part * 8); }
    };
    const int nkt = nkeys / 64;
    gload(0);
    for (int kt = 0; kt < nkt; ++kt) {
        __syncthreads();
#pragma unroll
        for (int i = 0; i < 3; ++i) { const int c = t + 256 * i, key = c / 12, part = c % 12; *(u32x4*)(sK + key * 208 + part * 16) = rk[i]; }
#pragma unroll
        for (int i = 0; i < 2; ++i) { const int c = t + 256 * i, row = c >> 3, part = c & 7; *(u32x4*)(sV + row * 144 + part * 16) = rv[i]; }
        __syncthreads();
        if (kt + 1 < nkt) gload(kt + 1);
#pragma unroll
        for (int sub = 0; sub < 2; ++sub) {
            f32x16 S;
#pragma unroll
            for (int i = 0; i < 16; ++i) S[i] = 0.f;
#pragma unroll
            for (int st = 0; st < 6; ++st) { const bf16x8 kf = *(const bf16x8*)(sK + (sub * 32 + r) * 208 + st * 32 + h2 * 16); S = __builtin_amdgcn_mfma_f32_32x32x16_bf16(kf, Qf[st], S, 0, 0, 0); }
            float mx = S[0];
#pragma unroll
            for (int i = 1; i < 16; ++i) mx = fmaxf(mx, S[i]);
            mx = fmaxf(mx, __shfl_xor(mx, 32, 64));
            const float mnew = fmaxf(mrun, mx), alpha = __builtin_amdgcn_exp2f(mrun - mnew);
            float ps = 0.f;
#pragma unroll
            for (int i = 0; i < 16; ++i) { S[i] = __builtin_amdgcn_exp2f(S[i] - mnew); ps += S[i]; }
            lsum = lsum * alpha + ps; mrun = mnew;
#pragma unroll
            for (int i = 0; i < 16; ++i) { O0[i] *= alpha; O1[i] *= alpha; }
#pragma unroll
            for (int s2 = 0; s2 < 2; ++s2) {
                const bf16x8 pb = pack8(S, s2);
                const int ko = (sub * 32 + 16 * s2 + 4 * h2) * 2;
                { const s16x4 lo = *(const s16x4*)(sV + r * 144 + ko), hi = *(const s16x4*)(sV + r * 144 + ko + 16);
                  const bf16x8 vf = __builtin_shufflevector(lo, hi, 0, 1, 2, 3, 4, 5, 6, 7); O0 = __builtin_amdgcn_mfma_f32_32x32x16_bf16(vf, pb, O0, 0, 0, 0); }
                { const s16x4 lo = *(const s16x4*)(sV + (32 + r) * 144 + ko), hi = *(const s16x4*)(sV + (32 + r) * 144 + ko + 16);
                  const bf16x8 vf = __builtin_shufflevector(lo, hi, 0, 1, 2, 3, 4, 5, 6, 7); O1 = __builtin_amdgcn_mfma_f32_32x32x16_bf16(vf, pb, O1, 0, 0, 0); }
            }
        }
    }
    lsum += __shfl_xor(lsum, 32, 64);
    const float inv = 1.f / lsum;
    bf16_t* y = p.Y + ((size_t)b * SU + sq) * DM + 768 + hh * 64;
#pragma unroll
    for (int g = 0; g < 4; ++g) {
        store_bf4(y + 8 * g + 4 * h2, (f32x4){O0[4 * g] * inv, O0[4 * g + 1] * inv, O0[4 * g + 2] * inv, O0[4 * g + 3] * inv});
        store_bf4(y + 32 + 8 * g + 4 * h2, (f32x4){O1[4 * g] * inv, O1[4 * g + 1] * inv, O1[4 * g + 2] * inv, O1[4 * g + 3] * inv});
    }
}
DI void ph_attn_sgm(const Params& p, int l, char* smem) {
    const int natt = 16 * 64 + (l == 0 ? 16 * 2 : 0);
    const int nsg = NB * NCHUNK * 4;
    for (int u = blockIdx.x; u < natt + nsg; u += gridDim.x) {
        if (u < natt) {
            if (u < 1024) { const int bh = u >> 6, qb = u & 63; attn_unit(p, bh >> 2, bh & 3, CTXL + qb * 128, SU, smem); }
            else { const int v = u - 1024, bh = v >> 1, qb = v & 1; attn_unit(p, bh >> 2, bh & 3, qb * 128, CTXL, smem); }
        } else {
            const int v = u - natt, g = v & 3, bc = v >> 2, b = bc / NCHUNK, c = bc % NCHUNK;
            if (l == 0 || c >= 2) sgm_unit(p, l, b, c, g, smem);
        }
    }
}

DI bool mt_active(int l, int mt) { return l == 0 || (mt % NCHUNK) >= 2; }
DI void ph_merge(const Params& p, int l, char* smem) {
    bf16_t* ACC = p.P;
    for (int u = blockIdx.x; u < NMT * 16; u += gridDim.x) {
        const int mt = u >> 4, nt = u & 15;
        if (!mt_active(l, mt)) continue;
        f32x4 out[4][2]; zero_acc(out);
        const bf16_t* Ah = p.H + (size_t)mt * 128 * DM; const bf16_t* Ay = p.Y + (size_t)mt * 128 * DM;
#pragma unroll 1
        for (int i = 0; i < 4; ++i) {
            unsigned pb[4][2][2];
            { f32x4 accB[4][2]; zero_acc(accB);
              gemm_tile(accB, [&](int r) { return Ay + (size_t)r * DM + i * 256; }, p.WbrT + ((size_t)i * DM + nt * 64) * 256, 256, 256, smem);
#pragma unroll
              for (int m = 0; m < 4; ++m)
#pragma unroll
                  for (int n = 0; n < 2; ++n) { pb[m][n][0] = pack2(accB[m][n][0], accB[m][n][1]); pb[m][n][1] = pack2(accB[m][n][2], accB[m][n][3]); } }
            f32x4 accG[4][2]; zero_acc(accG);
            gemm_tile(accG, [&](int r) { return Ah + (size_t)r * DM; }, p.WinT + ((size_t)OFF_GATE + i * DM + nt * 64) * DM, DM, DM, smem);
#pragma unroll
            for (int m = 0; m < 4; ++m)
#pragma unroll
                for (int n = 0; n < 2; ++n) {
                    out[m][n][0] += sigmoidf_(accG[m][n][0]) * __uint_as_float(pb[m][n][0] << 16);
                    out[m][n][1] += sigmoidf_(accG[m][n][1]) * __uint_as_float(pb[m][n][0] & 0xffff0000u);
                    out[m][n][2] += sigmoidf_(accG[m][n][2]) * __uint_as_float(pb[m][n][1] << 16);
                    out[m][n][3] += sigmoidf_(accG[m][n][3]) * __uint_as_float(pb[m][n][1] & 0xffff0000u);
                }
        }
        bf16_t* o = ACC + (size_t)mt * 128 * DM + nt * 64;
        for_frags(out, [&](int r, int c, f32x4 v) { store_bf4(o + (size_t)r * DM + c, v); });
    }
}

DI void ph_wout(const Params& p, int l, char* smem) {
    const bf16_t* ACC = p.P;
    for (int u = blockIdx.x; u < NMT * 8; u += gridDim.x) {
        const int mt = u >> 3, nt = u & 7;
        if (!mt_active(l, mt)) continue;
        f32x4 acc[4][4]; zero_acc(acc);
        const bf16_t* A = ACC + (size_t)mt * 128 * DM;
        gemm_tile(acc, [&](int r) { return A + (size_t)r * DM; }, p.WoutT + (size_t)nt * 128 * DM, DM, DM, smem);
        bf16_t* o = p.H + (size_t)mt * 128 * DM + nt * 128;
        for_frags(acc, [&](int r, int c, f32x4 v) { store_bf4(o + (size_t)r * DM + c, v); });
    }
}

DI void ph_r2(const Params& p, int l) {
    const int lane = threadIdx.x & 63, gw = blockIdx.x * 4 + (threadIdx.x >> 6), nw = gridDim.x * 4;
    for (int tok = gw; tok < NT; tok += nw) {
        if (l == 1 && tok_s(tok) < CTXL) continue;
        const float* xs = xrow_src(p, l, tok); float* xd = xrow_dst(p, tok);
        bf16_t* hrow = p.H + (size_t)tok * DM;
        const float* g1 = mod_row(p, l, tok, 2); const float* sh2 = mod_row(p, l, tok, 3); const float* sc2 = mod_row(p, l, tok, 4);
        f32x4 y[4]; float ss = 0.f;
#pragma unroll
        for (int i = 0; i < 4; ++i) { const u32x2 raw = *(const u32x2*)(hrow + lane * 4 + 256 * i);
            y[i][0] = __uint_as_float(raw[0] << 16); y[i][1] = __uint_as_float(raw[0] & 0xffff0000u); y[i][2] = __uint_as_float(raw[1] << 16); y[i][3] = __uint_as_float(raw[1] & 0xffff0000u);
            ss += y[i][0] * y[i][0] + y[i][1] * y[i][1] + y[i][2] * y[i][2] + y[i][3] * y[i][3]; }
        ss = wave_sum(ss); const float rstd = rsqrtf(ss * (1.f / DM) + EPS);
        f32x4 xn[4]; float ss2 = 0.f;
#pragma unroll
        for (int i = 0; i < 4; ++i) { const int d = lane * 4 + 256 * i; const f32x4 xv = *(const f32x4*)(xs + d), gp = *(const f32x4*)(p.g_post1 + (size_t)l * DM + d), gt = *(const f32x4*)(g1 + d);
#pragma unroll
            for (int j = 0; j < 4; ++j) { xn[i][j] = xv[j] + gt[j] * (y[i][j] * rstd * gp[j]); ss2 += xn[i][j] * xn[i][j]; }
            *(f32x4*)(xd + d) = xn[i]; }
        ss2 = wave_sum(ss2); const float rstd2 = rsqrtf(ss2 * (1.f / DM) + EPS);
        float lg[16];
#pragma unroll
        for (int e = 0; e < 16; ++e) lg[e] = 0.f;
#pragma unroll
        for (int i = 0; i < 4; ++i) { const int d = lane * 4 + 256 * i; const f32x4 gp = *(const f32x4*)(p.g_pre2 + (size_t)l * DM + d), s1 = *(const f32x4*)(sc2 + d), s0 = *(const f32x4*)(sh2 + d);
            f32x4 hv;
#pragma unroll
            for (int j = 0; j < 4; ++j) { hv[j] = xn[i][j] * rstd2 * gp[j] * (1.f + s1[j]) + s0[j];
                const float* rw = p.router_w + (size_t)(d + j) * 16;
#pragma unroll
                for (int e4 = 0; e4 < 4; ++e4) { const f32x4 wv = *(const f32x4*)(rw + e4 * 4); lg[e4 * 4 + 0] += hv[j] * wv[0]; lg[e4 * 4 + 1] += hv[j] * wv[1]; lg[e4 * 4 + 2] += hv[j] * wv[2]; lg[e4 * 4 + 3] += hv[j] * wv[3]; } }
            store_bf4(hrow + d, hv); }
#pragma unroll
        for (int e = 0; e < 16; ++e) lg[e] = wave_sum(lg[e]);
        if (lane == 0) {
            float aff[16], sel[16];
#pragma unroll
            for (int e = 0; e < 16; ++e) { aff[e] = sigmoidf_(lg[e]); sel[e] = aff[e] + p.router_bias[e]; }
            int best = 0; float bests = -1e30f;
#pragma unroll
            for (int g = 0; g < 4; ++g) { float m1 = -1e30f, m2 = -1e30f;
#pragma unroll
                for (int j = 0; j < 4; ++j) { const float v = sel[g * 4 + j]; if (v > m1) { m2 = m1; m1 = v; } else if (v > m2) m2 = v; }
                const float gs = m1 + m2; if (gs > bests) { bests = gs; best = g; } }
            int i0 = 0, i1 = 0; float m1 = -1e30f, m2 = -1e30f, a0 = 0.f, a1 = 0.f;
#pragma unroll
            for (int g = 0; g < 4; ++g)
#pragma unroll
                for (int j = 0; j < 4; ++j) if (g == best) { const float v = sel[g * 4 + j]; const float a = aff[g * 4 + j];
                    if (v > m1) { m2 = m1; i1 = i0; a1 = a0; m1 = v; i0 = g * 4 + j; a0 = a; } else if (v > m2) { m2 = v; i1 = g * 4 + j; a1 = a; } }
            const float inv = 1.f / (a0 + a1);
            p.ewt[(size_t)tok * 2] = a0 * inv; p.ewt[(size_t)tok * 2 + 1] = a1 * inv;
            const int p0 = atomicAdd(&p.cnt[i0], 1); p.elist[(size_t)i0 * NT + p0] = tok * 2;
            const int p1 = atomicAdd(&p.cnt[i1], 1); p.elist[(size_t)i1 * NT + p1] = tok * 2 + 1;
        }
    }
}

DI int sh_tok(int l, int pos) { return l == 0 ? pos : (pos >> 13) * SU + CTXL + (pos & 8191); }
DI void moe_offsets(const Params& p, int l, int* soff) {
    __syncthreads();
    if (threadIdx.x == 0) { int a = 0; for (int e = 0; e < 16; ++e) { const int c = p.cnt[e]; soff[e] = a; soff[17 + e] = c; a += c; } soff[16] = 2 * NT; soff[33] = l == 0 ? NT : NB * SEQ; }
    __syncthreads();
}
DI void ph_moe1(const Params& p, int l, char* smem) {
    int* soff = (int*)(smem + 32768);
    moe_offsets(p, l, soff);
    bf16_t* ACT = p.Y;
    for (int u = blockIdx.x; u < NMT * 17 * 2; u += gridDim.x) {
        const int nt = u & 1, e = (u >> 1) % 17, mt = (u >> 1) / 17;
        const int cnt = soff[17 + e];
        if (mt * 128 >= cnt) continue;
        const int* lst = p.elist + (size_t)e * NT;
        auto tokof = [&](int r) { int pos = mt * 128 + r; if (pos >= cnt) pos = mt * 128; return e < 16 ? (lst[pos] >> 1) : sh_tok(l, pos); };
        f32x4 a1[4][4], a3[4][4]; zero_acc(a1); zero_acc(a3);
        gemm_tile(a1, [&](int r) { return p.H + (size_t)tokof(r) * DM; }, p.W1T + ((size_t)e * 256 + nt * 128) * DM, DM, DM, smem);
        gemm_tile(a3, [&](int r) { return p.H + (size_t)tokof(r) * DM; }, p.W3T + ((size_t)e * 256 + nt * 128) * DM, DM, DM, smem);
#pragma unroll
        for (int m = 0; m < 4; ++m)
#pragma unroll
            for (int n = 0; n < 4; ++n)
#pragma unroll
                for (int j = 0; j < 4; ++j) a1[m][n][j] = siluf(a1[m][n][j]) * a3[m][n][j];
        bf16_t* o = ACT + ((size_t)soff[e] + mt * 128) * 256 + nt * 128;
        for_frags(a1, [&](int r, int c, f32x4 v) { if (mt * 128 + r < cnt) store_bf4(o + (size_t)r * 256 + c, v); });
    }
}
DI void ph_moe2(const Params& p, int l, char* smem) {
    int* soff = (int*)(smem + 32768);
    moe_offsets(p, l, soff);
    const bf16_t* ACT = p.Y; bf16_t* SLOT = p.P; bf16_t* SHOUT = p.H;
    for (int u = blockIdx.x; u < NMT * 17 * 8; u += gridDim.x) {
        const int nt = u & 7, e = (u >> 3) % 17, mt = (u >> 3) / 17;
        const int cnt = soff[17 + e];
        if (mt * 128 >= cnt) continue;
        const bf16_t* A = ACT + ((size_t)soff[e] + mt * 128) * 256;
        f32x4 acc[4][4]; zero_acc(acc);
        gemm_tile(acc, [&](int r) { const int rr = (mt * 128 + r < cnt) ? r : 0; return A + (size_t)rr * 256; }, p.W2T + ((size_t)e * DM + nt * 128) * 256, 256, 256, smem);
        const int* lst = p.elist + (size_t)e * NT;
        for_frags(acc, [&](int r, int c, f32x4 v) { const int pos = mt * 128 + r; if (pos < cnt) {
            if (e < 16) { const int pair = lst[pos]; const float w = p.ewt[pair]; store_bf4(SLOT + (size_t)pair * DM + nt * 128 + c, v * w); }
            else store_bf4(SHOUT + (size_t)sh_tok(l, pos) * DM + nt * 128 + c, v); } });
    }
}
DI f32x4 ld_bf4(const bf16_t* src) { const u32x2 raw = *(const u32x2*)src; f32x4 r; r[0] = __uint_as_float(raw[0] << 16); r[1] = __uint_as_float(raw[0] & 0xffff0000u); r[2] = __uint_as_float(raw[1] << 16); r[3] = __uint_as_float(raw[1] & 0xffff0000u); return r; }
DI void ph_final(const Params& p, int l) {
    const int lane = threadIdx.x & 63, gw = blockIdx.x * 4 + (threadIdx.x >> 6), nw = gridDim.x * 4;
    const bf16_t* SLOT = p.P; const bf16_t* SHOUT = p.H;
    for (int tok = gw; tok < NT; tok += nw) {
        if (l == 1 && tok_s(tok) < CTXL) continue;
        float* xd = xrow_dst(p, tok); const float* g2 = mod_row(p, l, tok, 5);
        f32x4 m[4]; float ss = 0.f;
#pragma unroll
        for (int i = 0; i < 4; ++i) { const int d = lane * 4 + 256 * i;
            m[i] = ld_bf4(SLOT + (size_t)tok * 2 * DM + d) + ld_bf4(SLOT + (size_t)tok * 2 * DM + DM + d) + ld_bf4(SHOUT + (size_t)tok * DM + d);
            ss += m[i][0] * m[i][0] + m[i][1] * m[i][1] + m[i][2] * m[i][2] + m[i][3] * m[i][3]; }
        ss = wave_sum(ss); const float rstd = rsqrtf(ss * (1.f / DM) + EPS);
#pragma unroll
        for (int i = 0; i < 4; ++i) { const int d = lane * 4 + 256 * i; const f32x4 xv = *(const f32x4*)(xd + d), gp = *(const f32x4*)(p.g_post2 + (size_t)l * DM + d), gt = *(const f32x4*)(g2 + d);
            f32x4 o;
#pragma unroll
            for (int j = 0; j < 4; ++j) o[j] = xv[j] + gt[j] * (m[i][j] * rstd * gp[j]);
            *(f32x4*)(xd + d) = o; }
    }
}

constexpr int SMEM_BYTES = 40960;
template <int PH>
__global__ void __launch_bounds__(NTHR, 2) k_phase(Params p, int l) {
    __shared__ __attribute__((aligned(16))) char smem[SMEM_BYTES];
    if (PH == 0) { ph_adaln(p, smem); __syncthreads(); ph_convert(p, 0, smem); }
    if (PH == 1) ph_norm1(p, l);
    if (PH == 2) ph_inproj(p, smem);
    if (PH == 3) ph_prep(p, l, smem);
    if (PH == 4) { if (blockIdx.x < 16) ph_scan(p, l); else ph_mla_up(p, blockIdx.x - 16, gridDim.x - 16, smem); }
    if (PH == 5) ph_fin(p, l);
    if (PH == 6) ph_attn_sgm(p, l, smem);
    if (PH == 7) ph_merge(p, l, smem);
    if (PH == 8) ph_wout(p, l, smem);
    if (PH == 9) ph_r2(p, l);
    if (PH == 10) ph_moe1(p, l, smem);
    if (PH == 11) ph_moe2(p, l, smem);
    if (PH == 12) { ph_final(p, l); if (l == 0) { __syncthreads(); ph_convert(p, 1, smem); } }
}

static size_t al256(size_t x) { return (x + 255) & ~(size_t)255; }
extern "C" void kernel_launch(void* const* d_in, const int* in_sizes, int n_in, void* d_out, int out_size, void* d_ws, size_t ws_size, hipStream_t stream) {
    Params p{};
    const float** fp = (const float**)&p.x;
    for (int i = 0; i < 33; ++i) fp[i] = (const float*)d_in[i];
    p.out = (float*)d_out;
    char* w = (char*)d_ws; size_t o = 0;
    auto take = [&](size_t bytes) { char* r = w + o; o = al256(o + bytes); return r; };
    p.bar = (unsigned*)take(16384);
    p.cnt = (int*)take(256);
    p.mod = (float*)take((size_t)2 * 5 * 6 * DM * 4);
    p.xc = (float*)take((size_t)NB * CTXL * DM * 4);
    p.WinT = (bf16_t*)take((size_t)INC * DM * 2);
    p.WbrT = (bf16_t*)take((size_t)4 * DM * 256 * 2);
    p.WoutT = (bf16_t*)take((size_t)DM * DM * 2);
    p.W1T = (bf16_t*)take((size_t)17 * 256 * DM * 2);
    p.W3T = (bf16_t*)take((size_t)17 * 256 * DM * 2);
    p.W2T = (bf16_t*)take((size_t)17 * DM * 256 * 2);
    p.WuqT = (bf16_t*)take((size_t)384 * 256 * 2);
    p.WukvT = (bf16_t*)take((size_t)512 * 128 * 2);
    p.H = (bf16_t*)take((size_t)NT * DM * 2);
    p.P = (bf16_t*)take((size_t)NT * PW * 2);
    p.DNQKV = (bf16_t*)take((size_t)NT * 768 * 2);
    p.Y = (bf16_t*)take((size_t)NT * DM * 2);
    p.MQ = (bf16_t*)take((size_t)NT * 384 * 2);
    p.MK = (bf16_t*)take((size_t)NT * 384 * 2);
    p.MVT = (bf16_t*)take((size_t)NT * 256 * 2);
    p.DG = (float*)take((size_t)NT * 8 * 4);
    p.DB = (float*)take((size_t)NT * 8 * 4);
    p.ewt = (float*)take((size_t)NT * 2 * 4);
    p.elist = (int*)take((size_t)16 * NT * 4);
    if (o > ws_size) { fprintf(stderr, "workspace too small: need %zu have %zu\n", o, ws_size); return; }
    const int G = 512;
    k_phase<0><<<G, NTHR, 0, stream>>>(p, 0);
    for (int l = 0; l < 2; ++l) {
        k_phase<1><<<G, NTHR, 0, stream>>>(p, l);
        k_phase<2><<<G, NTHR, 0, stream>>>(p, l);
        k_phase<3><<<G, NTHR, 0, stream>>>(p, l);
        k_phase<4><<<G, NTHR, 0, stream>>>(p, l);
        k_phase<5><<<G, NTHR, 0, stream>>>(p, l);
        k_phase<6><<<G, NTHR, 0, stream>>>(p, l);
        k_phase<7><<<G, NTHR, 0, stream>>>(p, l);
        k_phase<8><<<G, NTHR, 0, stream>>>(p, l);
        k_phase<9><<<G, NTHR, 0, stream>>>(p, l);
        k_phase<10><<<G, NTHR, 0, stream>>>(p, l);
        k_phase<11><<<G, NTHR, 0, stream>>>(p, l);
        k_phase<12><<<G, NTHR, 0, stream>>>(p, l);
    }
}
```

```cpp
#include <hip/hip_runtime.h>
#include <stdint.h>
#include <stdio.h>

#ifndef RET_NEW
#define RET_NEW 1
#endif
#ifndef DN_NEW
#define DN_NEW 1
#endif
#ifndef REP_INPROJ
#define REP_INPROJ 1
#define REP_LOCAL 1
#define REP_OUTPUT 1
#define REP_MERGE 1
#define REP_WOUT 1
#define REP_MOE 1
#define REP_DNSCAN 1
#define REP_ATT 1
#define REP_SG 1
#define REP_RO 1
#define REP_DO 1
#define REP_DNL 1
#define REP_RKV 1
#define REP_MLA 1
#define DRY_PREP 0
#define DRY_R2 0
#define DRY_FINAL 0
#endif
#ifndef MK_ONE_LAUNCH
#define MK_ONE_LAUNCH 1
#endif

typedef unsigned short bf16_t;
typedef short bf16x8 __attribute__((ext_vector_type(8)));
typedef short s16x4 __attribute__((ext_vector_type(4)));
typedef float f32x4 __attribute__((ext_vector_type(4)));
typedef float f32x16 __attribute__((ext_vector_type(16)));
typedef unsigned u32x4 __attribute__((ext_vector_type(4)));
typedef unsigned u32x2 __attribute__((ext_vector_type(2)));
#define DI __device__ __forceinline__

constexpr int NB = 4, SEQ = 8192, CTXL = 256, SU = SEQ + CTXL, NT = NB * SU, DM = 1024;
constexpr int PW = 2224, INC = 7088, PWFULL = 2992;
constexpr int OFF_SG = 1024, OFF_DNZ = 1536, OFF_MLA = 1808, OFF_GATE = 2992;
constexpr int NCHUNK = SU / 128;
constexpr int NMT = NT / 128;
constexpr float EPS = 1e-6f;
constexpr int NTHR = 256;

struct Params {
    const float *x, *c, *ctx, *c_ctx, *w_ada, *b_ada, *g_pre1, *g_post1, *g_pre2, *g_post2, *w_in, *ret_logit, *sg_norm_g, *sg_w, *sg_b,
        *dn_conv_w, *dn_A_log, *dn_dt_bias, *dn_norm_g, *mla_q_norm_g, *mla_kv_norm_g, *mla_w_uq, *mla_w_ukv, *w_branch, *w_out,
        *router_w, *router_bias, *moe_w1, *moe_w3, *moe_w2, *sh_w1, *sh_w3, *sh_w2;
    float* out;
    unsigned* bar; int* cnt; float* mod; float* xc;
    bf16_t *WinT, *WbrT, *WoutT, *W1T, *W3T, *W2T, *WuqT, *WukvT;
    bf16_t *H, *P, *DNQKV, *Y, *MQ, *MK, *MVT, *DNRAW, *RS, *DNM, *DNN, *DSP, *SGW;
    float* ROT;
    float *DG, *DB, *ewt;
    int* elist;
};

#define XB_TMO      128
#define XB_XCNT(j)  (256  + 64 * (j))
#define XB_XSUB(j)  (1280 + 64 * (j))
#define XB_XGEN(j)  (2304 + 64 * (j))
#define XB_TOP      3328
#define XB_TOPGEN   3392
#define XCD_BAR_WORDS 3456
#define XB_SPIN_CAP (1u << 21)
#define LAS __attribute__((address_space(3)))

__device__ __forceinline__ unsigned xb_ld(unsigned* p)              { return __hip_atomic_load(p, __ATOMIC_RELAXED, __HIP_MEMORY_SCOPE_AGENT); }
__device__ __forceinline__ unsigned xb_add(unsigned* p, unsigned v) { return __hip_atomic_fetch_add(p, v, __ATOMIC_RELAXED, __HIP_MEMORY_SCOPE_AGENT); }
__device__ __forceinline__ unsigned xb_xcc_id() { return (unsigned)__builtin_amdgcn_s_getreg((3 << 11) | 20) & 0xFu; }
#define XB_SPIN(cond, bar) do { unsigned _sp = 0; while (cond) { __builtin_amdgcn_s_sleep(1); \
    if ((++_sp & 255u) == 0u) { if (xb_ld(&(bar)[XB_TMO])) break; if (_sp > XB_SPIN_CAP) { atomicAdd(&(bar)[XB_TMO], 1u); break; } } } } while (0)

struct XcdBarrier {
    unsigned* bar; unsigned x;
    volatile LAS unsigned* st;
};

__device__ __forceinline__ XcdBarrier xcd_barrier_post(unsigned* bar, volatile LAS unsigned* st) {
    XcdBarrier b; b.bar = bar; b.x = xb_xcc_id(); b.st = st;
    if (threadIdx.x == 0) (void)xb_add(&bar[XB_XCNT(b.x)], 1u);
    return b;
}
__device__ __forceinline__ void xcd_barrier_complete(unsigned* bar, unsigned x, unsigned& nloc, unsigned& nx) {
    const unsigned G = gridDim.x * gridDim.y * gridDim.z;
    unsigned sum, cnt, mine, sp = 0u;
    for (;;) {
        sum = 0u; cnt = 0u; mine = 0u;
#pragma unroll
        for (unsigned j = 0; j < 16; ++j) { const unsigned c = xb_ld(&bar[XB_XCNT(j)]); sum += c; cnt += (c > 0u) ? 1u : 0u; mine = (j == x) ? c : mine; }
        if (sum == G) break;
        __builtin_amdgcn_s_sleep(1);
        if ((++sp & 255u) == 0u) { if (xb_ld(&bar[XB_TMO])) break; if (sp > XB_SPIN_CAP) { atomicAdd(&bar[XB_TMO], 1u); break; } }
    }
    nloc = mine > 0u ? mine : 1u; nx = cnt > 0u ? cnt : 1u;
}

__device__ __forceinline__ void xcd_barrier(const XcdBarrier& b) {
    asm volatile("s_waitcnt vmcnt(0)" ::: "memory");
    __syncthreads();
    if (threadIdx.x == 0) {
        unsigned* bar = b.bar;
        __builtin_amdgcn_s_waitcnt(0);
        unsigned nloc = b.st[0], nx = b.st[1];
        if (nloc == 0u) { xcd_barrier_complete(bar, b.x, nloc, nx); b.st[0] = nloc; b.st[1] = nx; }
        const unsigned old = xb_add(&bar[XB_XSUB(b.x)], 1u);
        const unsigned gen = old / nloc;
        if (old + 1u == (gen + 1u) * nloc) {
            __builtin_amdgcn_fence(__ATOMIC_RELEASE, "agent");
            asm volatile("s_waitcnt vmcnt(0)" ::: "memory");
            const unsigned og = xb_add(&bar[XB_TOP], 1u);
            const unsigned tg = og / nx;
            if (og + 1u == (tg + 1u) * nx) xb_add(&bar[XB_TOPGEN], 1u);
            else XB_SPIN(xb_ld(&bar[XB_TOPGEN]) == tg, bar);
            __builtin_amdgcn_fence(__ATOMIC_ACQUIRE, "agent");
            xb_add(&bar[XB_XGEN(b.x)], 1u);
            asm volatile("s_waitcnt vmcnt(0)" ::: "memory");
        } else {
            XB_SPIN(xb_ld(&bar[XB_XGEN(b.x)]) == gen, bar);
            __builtin_amdgcn_fence(__ATOMIC_ACQUIRE, "agent");
            asm volatile("s_waitcnt vmcnt(0)" ::: "memory");
        }
    }
    __syncthreads();
}


typedef const Params LAS* PP;
#define PARAM_FIELDS(X) X(x) X(c) X(ctx) X(c_ctx) X(w_ada) X(b_ada) X(g_pre1) X(g_post1) X(g_pre2) X(g_post2) X(w_in) X(ret_logit) X(sg_norm_g) X(sg_w) X(sg_b) X(dn_conv_w) X(dn_A_log) X(dn_dt_bias) X(dn_norm_g) X(mla_q_norm_g) X(mla_kv_norm_g) X(mla_w_uq) X(mla_w_ukv) X(w_branch) X(w_out) X(router_w) X(router_bias) X(moe_w1) X(moe_w3) X(moe_w2) X(sh_w1) X(sh_w3) X(sh_w2) X(out) X(bar) X(cnt) X(mod) X(xc) X(WinT) X(WbrT) X(WoutT) X(W1T) X(W3T) X(W2T) X(WuqT) X(WukvT) X(H) X(P) X(DNQKV) X(Y) X(MQ) X(MK) X(MVT) X(DG) X(DB) X(ewt) X(elist)
DI Params load_params(PP pp) {
    Params p;
#define X(f) p.f = pp->f;
    PARAM_FIELDS(X)
#undef X
    return p;
}
DI const Params* kparams() { const Params* kp = (const Params*)__builtin_amdgcn_kernarg_segment_ptr(); asm volatile("" : "+s"(kp)); return kp; }
DI int tidx() { int t = threadIdx.x; asm volatile("" : "+v"(t)); return t; }
DI int bidx() { int b = blockIdx.x; asm volatile("" : "+s"(b)); return b; }
DI int gdim() { int g = gridDim.x; asm volatile("" : "+s"(g)); return g; }
DI float bf2f(bf16_t v) { return __uint_as_float((unsigned)v << 16); }
typedef __bf16 hbf2 __attribute__((ext_vector_type(2)));
typedef float hf2 __attribute__((ext_vector_type(2)));
DI unsigned pack2(float lo, float hi) { const hf2 f = {lo, hi}; return __builtin_bit_cast(unsigned, __builtin_convertvector(f, hbf2)); }
DI bf16_t f2bf(float f) { return (bf16_t)(pack2(f, 0.f) & 0xffffu); }
DI float wave_sum(float v) {
#pragma unroll
    for (int o = 32; o > 0; o >>= 1) v += __shfl_xor(v, o, 64);
    return v;
}
DI float sigmoidf_(float x) { return __builtin_amdgcn_rcpf(1.f + __builtin_amdgcn_exp2f(-1.4426950408889634f * x)); }
DI float sig2(float y) { return __builtin_amdgcn_rcpf(1.f + __builtin_amdgcn_exp2f(y)); }
DI float siluf(float x) { return x * sigmoidf_(x); }
DI float gelu_tanh(float x) { const float u = 0.7978845608028654f * (x + 0.044715f * x * x * x); return x * __builtin_amdgcn_rcpf(1.f + __builtin_amdgcn_exp2f(-2.8853900817779268f * u)); }
DI float softplusf_(float x) { return x > 20.f ? x : log1pf(expf(x)); }
DI int tok_b(int tok) { return tok / SU; }
DI int tok_s(int tok) { return tok % SU; }
DI void block_sum4(float& a, float& b, float& c, float& d, LAS float* red) {
    a = wave_sum(a); b = wave_sum(b); c = wave_sum(c); d = wave_sum(d);
    const int w = tidx() >> 6, lane = tidx() & 63;
    __syncthreads();
    if (lane == 0) { red[w * 4 + 0] = a; red[w * 4 + 1] = b; red[w * 4 + 2] = c; red[w * 4 + 3] = d; }
    __syncthreads();
    a = red[0] + red[4] + red[8] + red[12]; b = red[1] + red[5] + red[9] + red[13];
    c = red[2] + red[6] + red[10] + red[14]; d = red[3] + red[7] + red[11] + red[15];
}

DI void glds16(const void* base, unsigned voff, unsigned lds_dst) {
    unsigned keep;
    asm volatile("s_nop 4\n\ts_mov_b32 %0, m0\n\ts_mov_b32 m0, %3\n\ts_nop 0\n\tglobal_load_lds_dwordx4 %1, %2\n\ts_mov_b32 m0, %0" : "=&s"(keep) : "v"(voff), "s"(base), "s"(lds_dst) : "memory");
}
DI int perm32(int rho) { const int n = rho >> 4, i = rho & 15; return 8 * (i >> 2) + 4 * n + (i & 3); }
DI int brow_src(int rr) { return (rr & ~31) + perm32(rr & 31); }
DI const bf16_t* uniform_ptr(const bf16_t* q) {
    const unsigned long long v = (unsigned long long)q;
    const unsigned lo = (unsigned)__builtin_amdgcn_readfirstlane((int)(unsigned)v), hi = (unsigned)__builtin_amdgcn_readfirstlane((int)(unsigned)(v >> 32));
    return (const bf16_t*)(((unsigned long long)hi << 32) | lo);
}
template <int NF, class ARowF>
DI void gemm_prestage(const bf16_t* __restrict__ Abase, ARowF arow, const bf16_t* __restrict__ Bt, int ldb, LAS char* smem) {
    const int t = tidx(), lane = t & 63, wave = t >> 6, lrow = lane >> 3, lch = (lane & 7) ^ lrow;
    const unsigned ldsw = (unsigned)__builtin_amdgcn_readfirstlane((int)((unsigned)(size_t)smem + wave * 1024));
    const bf16_t* Au = uniform_ptr(Abase); const bf16_t* Bu = uniform_ptr(Bt);
#pragma unroll
    for (int i = 0; i < 4; ++i) glds16(Au, ((unsigned)arow((wave + 4 * i) * 8 + lrow) + lch * 8) * 2, ldsw + i * 4096);
#pragma unroll
    for (int i = 0; i < NF; ++i) glds16(Bu, (unsigned)(brow_src((wave + 4 * i) * 8 + lrow) * ldb + lch * 8) * 2, ldsw + 16384 + i * 4096);
}
struct NoNext { DI void operator()() const {} };
template <bool PIPE = true, int NF, class ARowF, class BRowF, class NextF = NoNext>
DI void gemm_tile_g(f32x4 (&acc)[4][NF], const bf16_t* __restrict__ Abase, ARowF arow, const bf16_t* __restrict__ Bt, BRowF brow, int K, LAS char* smem, bool pre = false, NextF next = NextF()) {
    const int t = tidx(), lane = t & 63, wave = t >> 6, wr = wave >> 1, wc = wave & 1, fr = lane & 15, fq = lane >> 4;
    const int lrow = lane >> 3, lch = (lane & 7) ^ lrow;
    unsigned ao[4], bo[NF];
#pragma unroll
    for (int i = 0; i < 4; ++i) ao[i] = ((unsigned)arow((wave + 4 * i) * 8 + lrow) + lch * 8) * 2;
#pragma unroll
    for (int i = 0; i < NF; ++i) bo[i] = ((unsigned)brow((wave + 4 * i) * 8 + lrow) + lch * 8) * 2;
    const unsigned ldsw = (unsigned)__builtin_amdgcn_readfirstlane((int)((unsigned)(size_t)smem + wave * 1024));
    const bf16_t* Au = uniform_ptr(Abase); const bf16_t* Bu = uniform_ptr(Bt);
    auto stage = [&](int buf, int k0) {
        const unsigned dA = ldsw + buf * 32768, dB = dA + 16384;
#pragma unroll
        for (int i = 0; i < 4; ++i) glds16(Au + k0, ao[i], dA + i * 4096);
#pragma unroll
        for (int i = 0; i < NF; ++i) glds16(Bu + k0, bo[i], dB + i * 4096);
    };
    __syncthreads();
    if (!pre) stage(0, 0);
    asm volatile("s_waitcnt vmcnt(0)" ::: "memory");
    __syncthreads();
    const int nk = K >> 6;
    const int sw = (fq ^ (fr & 7)) * 16;
    const int aoff0 = (wr * 64 + fr) * 128 + sw, boff0 = (wc * 16 * NF + fr) * 128 + sw + 16384;
    bf16x8 af0[4], bf0[NF], af1[4], bf1[NF];
    auto ldfrag = [&](const LAS char* sA, int kk, bf16x8 (&af)[4], bf16x8 (&bf)[NF]) {
        const LAS char* pa = sA + (kk ? (aoff0 ^ 64) : aoff0); const LAS char* pb_ = sA + (kk ? (boff0 ^ 64) : boff0);
#pragma unroll
        for (int m = 0; m < 4; ++m) af[m] = *(const LAS bf16x8*)(pa + m * 2048);
#pragma unroll
        for (int n = 0; n < NF; ++n) bf[n] = *(const LAS bf16x8*)(pb_ + n * 2048);
    };
    auto mma = [&](const bf16x8 (&af)[4], const bf16x8 (&bf)[NF]) {
#pragma unroll
        for (int m = 0; m < 4; ++m)
#pragma unroll
            for (int n = 0; n < NF; ++n) acc[m][n] = __builtin_amdgcn_mfma_f32_16x16x32_bf16(bf[n], af[m], acc[m][n], 0, 0, 0);
    };
    if (nk > 1) stage(1, 64);
    if (!PIPE) {
        for (int kt = 0; kt < nk; ++kt) {
            const LAS char* sA = smem + (kt & 1) * 32768;
            ldfrag(sA, 0, af0, bf0); mma(af0, bf0);
            ldfrag(sA, 1, af0, bf0); mma(af0, bf0);
            asm volatile("s_waitcnt vmcnt(0)" ::: "memory");
            __syncthreads();
            if (kt + 2 < nk) stage(kt & 1, (kt + 2) * 64); else if (kt + 2 == nk) next();
        }
        return;
    }
    ldfrag(smem, 0, af0, bf0);
    for (int kt = 0; kt < nk; ++kt) {
        const LAS char* sA = smem + (kt & 1) * 32768;
        ldfrag(sA, 1, af1, bf1);
        mma(af0, bf0);
        asm volatile("s_waitcnt vmcnt(0)" ::: "memory");
        __syncthreads();
        if (kt + 2 < nk) stage(kt & 1, (kt + 2) * 64); else if (kt + 2 == nk) next();
        if (kt + 1 < nk) ldfrag(smem + ((kt + 1) & 1) * 32768, 0, af0, bf0);
        mma(af1, bf1);
    }
}
template <bool PIPE = true, int NF, class ARowF, class NextF = NoNext>
DI void gemm_tile(f32x4 (&acc)[4][NF], const bf16_t* __restrict__ Abase, ARowF arow, const bf16_t* __restrict__ Bt, int ldb, int K, LAS char* smem, bool pre = false, NextF next = NextF()) {
    gemm_tile_g<PIPE>(acc, Abase, arow, Bt, [&](int rr) { return brow_src(rr) * ldb; }, K, smem, pre, next);
}
template <int NF>
DI void zero_acc(f32x4 (&acc)[4][NF]) {
#pragma unroll
    for (int m = 0; m < 4; ++m)
#pragma unroll
        for (int n = 0; n < NF; ++n) acc[m][n] = (f32x4){0.f, 0.f, 0.f, 0.f};
}
template <int NF, class F>
DI void for_frags(const f32x4 (&acc)[4][NF], F f) {
    const int t = tidx(), lane = t & 63, wave = t >> 6, wr = wave >> 1, wc = wave & 1, fr = lane & 15, fq = lane >> 4;
#pragma unroll
    for (int m = 0; m < 4; ++m)
#pragma unroll
        for (int k = 0; k < NF / 2; ++k) f(wr * 64 + m * 16 + fr, wc * 16 * NF + k * 32 + fq * 8, acc[m][2 * k], acc[m][2 * k + 1]);
}
DI f32x4 ld_bf4(const bf16_t* src) { const u32x2 raw = *(const u32x2*)src; f32x4 r; r[0] = __uint_as_float(raw[0] << 16); r[1] = __uint_as_float(raw[0] & 0xffff0000u); r[2] = __uint_as_float(raw[1] << 16); r[3] = __uint_as_float(raw[1] & 0xffff0000u); return r; }
DI void store_bf8(bf16_t* dst, f32x4 lo, f32x4 hi) { u32x4 o; o[0] = pack2(lo[0], lo[1]); o[1] = pack2(lo[2], lo[3]); o[2] = pack2(hi[0], hi[1]); o[3] = pack2(hi[2], hi[3]); *(u32x4*)dst = o; }
DI void store_bf4(bf16_t* dst, f32x4 v) { u32x2 o; o[0] = pack2(v[0], v[1]); o[1] = pack2(v[2], v[3]); *(u32x2*)dst = o; }

struct TJob { const float* src; bf16_t* dst; int K, N, nscale; };
constexpr int NJOBS = 59;
DI TJob get_job(const Params& p, int l, int j) {
    TJob r; r.nscale = 1 << 30;
    if (j == 0) { r.src = p.w_in + (size_t)l * DM * INC; r.dst = p.WinT; r.K = DM; r.N = INC; r.nscale = OFF_GATE; }
    else if (j < 5) { const int i = j - 1; r.src = p.w_branch + ((size_t)l * 4 + i) * 256 * DM; r.dst = p.WbrT + (size_t)i * DM * 256; r.K = 256; r.N = DM; }
    else if (j == 5) { r.src = p.w_out + (size_t)l * DM * DM; r.dst = p.WoutT; r.K = DM; r.N = DM; }
    else if (j < 23) { const int e = j - 6; r.src = e < 16 ? p.moe_w1 + ((size_t)l * 16 + e) * DM * 256 : p.sh_w1 + (size_t)l * DM * 256; r.dst = p.W1T + (size_t)e * 256 * DM; r.K = DM; r.N = 256; }
    else if (j < 40) { const int e = j - 23; r.src = e < 16 ? p.moe_w3 + ((size_t)l * 16 + e) * DM * 256 : p.sh_w3 + (size_t)l * DM * 256; r.dst = p.W3T + (size_t)e * 256 * DM; r.K = DM; r.N = 256; }
    else if (j < 57) { const int e = j - 40; r.src = e < 16 ? p.moe_w2 + ((size_t)l * 16 + e) * 256 * DM : p.sh_w2 + (size_t)l * 256 * DM; r.dst = p.W2T + (size_t)e * DM * 256; r.K = 256; r.N = DM; }
    else if (j == 57) { r.src = p.mla_w_uq + (size_t)l * 256 * 384; r.dst = p.WuqT; r.K = 256; r.N = 384; }
    else { r.src = p.mla_w_ukv + (size_t)l * 128 * 512; r.dst = p.WukvT; r.K = 128; r.N = 512; }
    return r;
}
DI void ph_convert(const Params& p, int l, LAS char* smem) {
    LAS float* tile = (LAS float*)smem;
    const int t = tidx(), G = gdim();
    int base = 0;
    for (int j = 0; j < NJOBS; ++j) {
        const TJob jb = get_job(p, l, j);
        const int tn = (jb.N + 63) / 64, nt = (jb.K / 64) * tn;
        const int first = (int)(((long)bidx() - base) % G + G) % G;
        for (int ti = first; ti < nt; ti += G) {
            const int k0 = (ti / tn) * 64, n0 = (ti % tn) * 64;
            __syncthreads();
            f32x4 ld[4];
#pragma unroll
            for (int i = 0; i < 4; ++i) { const int kr = (t >> 4) + 16 * i, nc = (t & 15) * 4; ld[i] = (n0 + nc < jb.N) ? *(const f32x4*)(jb.src + (size_t)(k0 + kr) * jb.N + n0 + nc) : (f32x4){0.f, 0.f, 0.f, 0.f}; }
#pragma unroll
            for (int i = 0; i < 4; ++i) { const int kr = (t >> 4) + 16 * i, nc = (t & 15) * 4;
#pragma unroll
                for (int q = 0; q < 4; ++q) tile[kr * 65 + nc + q] = ld[i][q]; }
            __syncthreads();
#pragma unroll
            for (int i = 0; i < 2; ++i) { const int c = t + 256 * i, nr = c >> 3, kc = (c & 7) * 8; const float sc = (n0 + nr >= jb.nscale) ? -1.4426950408889634f : 1.f;
                u32x4 o;
#pragma unroll
                for (int q = 0; q < 4; ++q) o[q] = pack2(tile[(kc + 2 * q) * 65 + nr] * sc, tile[(kc + 2 * q + 1) * 65 + nr] * sc);
                if (n0 + nr < jb.N) *(u32x4*)(jb.dst + (size_t)(n0 + nr) * jb.K + k0 + kc) = o; }
        }
        base += nt;
    }
    for (int i = bidx() * NTHR + t; i < 4 * 128 * 128 / 4; i += G * NTHR) store_bf4(p.SGW + (size_t)i * 4, *(const f32x4*)(p.sg_w + (size_t)l * 4 * 128 * 128 + (size_t)i * 4));
}

DI void ph_rot_table(const Params& p) {
    for (int i = bidx() * NTHR + tidx(); i < SEQ * 32; i += gdim() * NTHR) { const int n = i >> 5, d = i & 31;
        float sn, cs; sincosf((float)n * exp2f(-(float)d * (13.287712379549449f / 32.f)), &sn, &cs); p.ROT[2 * i] = cs; p.ROT[2 * i + 1] = sn; }
    for (int i = bidx() * NTHR + tidx(); i < 128 * 8; i += gdim() * NTHR) { float sn, cs; sincosf((float)(i >> 3) * exp2f(-(float)(i & 7) * (13.287712379549449f / 8.f)), &sn, &cs);
        p.ROT[(size_t)SEQ * 64 + 2 * i] = cs; p.ROT[(size_t)SEQ * 64 + 2 * i + 1] = sn; }
}
DI void ph_adaln(const Params& p, LAS char* smem) {
    LAS float* sc = (LAS float*)smem;
    LAS float* red = sc + 5 * DM;
    const int t = tidx();
    for (int i = t; i < 5 * DM; i += NTHR) { const int r = i / DM, k = i % DM; const float v = r < 4 ? p.c[r * DM + k] : p.c_ctx[k]; sc[i] = siluf(v); }
    __syncthreads();
    for (int u = bidx(); u < 2 * 96; u += gdim()) {
        const int l = u / 96, cg = u % 96, col = cg * 64 + (t & 63), kg = t >> 6;
        float a[5] = {0.f, 0.f, 0.f, 0.f, 0.f};
        const float* w = p.w_ada + (size_t)l * DM * 6 * DM + col;
        for (int k = kg * 256; k < kg * 256 + 256; k += 16) { float wv[16];
#pragma unroll
            for (int kk = 0; kk < 16; ++kk) wv[kk] = w[(size_t)(k + kk) * 6 * DM];
#pragma unroll
            for (int kk = 0; kk < 16; ++kk)
#pragma unroll
                for (int r = 0; r < 5; ++r) a[r] += sc[r * DM + k + kk] * wv[kk]; }
        __syncthreads();
#pragma unroll
        for (int r = 0; r < 5; ++r) red[(kg * 5 + r) * 64 + (t & 63)] = a[r];
        __syncthreads();
        if (kg == 0) {
#pragma unroll
            for (int r = 0; r < 5; ++r) { const float s = red[(0 * 5 + r) * 64 + t] + red[(1 * 5 + r) * 64 + t] + red[(2 * 5 + r) * 64 + t] + red[(3 * 5 + r) * 64 + t];
                p.mod[((size_t)l * 5 + r) * 6 * DM + col] = s + p.b_ada[(size_t)l * 6 * DM + col]; }
        }
    }
}

DI const float* xrow_src(const Params& p, int l, int tok) {
    const int b = tok_b(tok), s = tok_s(tok);
    if (s < CTXL) return (l == 0 ? p.ctx : p.xc) + ((size_t)b * CTXL + s) * DM;
    return (l == 0 ? p.x : p.out) + ((size_t)b * SEQ + (s - CTXL)) * DM;
}
DI float* xrow_dst(const Params& p, int tok) {
    const int b = tok_b(tok), s = tok_s(tok);
    if (s < CTXL) return p.xc + ((size_t)b * CTXL + s) * DM;
    return p.out + ((size_t)b * SEQ + (s - CTXL)) * DM;
}
DI const float* mod_row(const Params& p, int l, int tok, int i) { const int b = tok_b(tok), s = tok_s(tok); const int r = s < CTXL ? 4 : b; return p.mod + (((size_t)l * 5 + r) * 6 + i) * DM; }

DI void ph_norm1(const Params& p, int l) {
    const int lane = tidx() & 63, gw = bidx() * 4 + (tidx() >> 6), nw = gdim() * 4;
    if (bidx() == 0 && tidx() < 32) p.cnt[tidx()] = 0;
    const float* g = p.g_pre1 + (size_t)l * DM;
    f32x4 v[4], v1[4], v2[4];
    auto ldrow = [&](int tok, f32x4 (&d)[4]) { if (tok < NT) { const float* src = xrow_src(p, l, tok);
#pragma unroll
        for (int i = 0; i < 4; ++i) d[i] = *(const f32x4*)(src + lane * 4 + 256 * i); } };
    ldrow(gw, v); ldrow(gw + nw, v1);
    for (int tok = gw; tok < NT; tok += nw) {
        ldrow(tok + 2 * nw, v2);
        const float* sh = mod_row(p, l, tok, 0); const float* scl = mod_row(p, l, tok, 1);
        float ss = 0.f;
#pragma unroll
        for (int i = 0; i < 4; ++i) ss += v[i][0] * v[i][0] + v[i][1] * v[i][1] + v[i][2] * v[i][2] + v[i][3] * v[i][3];
        ss = wave_sum(ss); const float rstd = rsqrtf(ss * (1.f / DM) + EPS);
#pragma unroll
        for (int i = 0; i < 4; ++i) { const int d = lane * 4 + 256 * i; const f32x4 gg = *(const f32x4*)(g + d), s1 = *(const f32x4*)(scl + d), s0 = *(const f32x4*)(sh + d);
            f32x4 o;
#pragma unroll
            for (int j = 0; j < 4; ++j) o[j] = v[i][j] * rstd * gg[j] * (1.f + s1[j]) + s0[j];
            store_bf4(p.H + (size_t)tok * DM + d, o); }
#pragma unroll
        for (int i = 0; i < 4; ++i) { v[i] = v1[i]; v1[i] = v2[i]; }
    }
}

struct TileDeal { int x, lb, gl, R, nn, total; };
DI TileDeal deal_init(int nm, int nn) { TileDeal d; const int b = bidx(), g = gdim(); d.x = b & 7; d.lb = b >> 3; d.gl = g >> 3; d.R = nm >> 3; d.nn = nn; d.total = d.R * nn; return d; }
DI void deal_map(const TileDeal& d, int j, int& mt, int& nt) {
    const int bs = 8 * d.nn; const int band = j / bs, jj = j - band * bs;
    nt = jj >> 3; const int lt = d.x * d.R + band * 8 + (jj & 7);
    mt = (lt >> 6) * NCHUNK + 2 + (lt & 63);
}
DI int ctx_mt(int c8) { return (c8 >> 1) * NCHUNK + (c8 & 1); }
template <int NF, class NextF = NoNext>
DI void inproj_unit(const Params& p, int mt, int nt, LAS char* smem, bool pre = false, NextF next = NextF()) {
    f32x4 acc[4][NF]; zero_acc(acc);
    const bf16_t* A = p.H + (size_t)mt * 128 * DM;
    gemm_tile(acc, A, [&](int r) { return r * DM; }, p.WinT + (size_t)nt * 32 * NF * DM, DM, DM, smem, pre, next);
    for_frags(acc, [&](int r, int c, f32x4 lo, f32x4 hi) { const int col = nt * 32 * NF + c; const size_t row = (size_t)mt * 128 + r;
        if (col < 1536) store_bf8(p.P + row * PW + col, lo, hi);
        else if (col < 2304) store_bf8(p.DNRAW + row * 768 + (col - 1536), lo, hi);
        else if (col < PWFULL) store_bf8(p.P + row * PW + (col - 768), lo, hi); });
}
DI void ph_inproj(const Params& p, LAS char* smem) {
    const TileDeal dl = deal_init(256, 24);
    bool pre = false;
    for (int j = dl.lb; j < dl.total; j += dl.gl) { int mt, nt; deal_map(dl, j, mt, nt);
        const int jn = j + dl.gl; const bool hasn = jn < dl.total; int mtn = 0, ntn = 0; if (hasn) deal_map(dl, jn, mtn, ntn);
        inproj_unit<4>(p, mt, nt, smem, pre, [&]() { if (hasn) gemm_prestage<4>(p.H + (size_t)mtn * 128 * DM, [&](int r) { return r * DM; }, p.WinT + (size_t)ntn * 128 * DM, DM, smem); });
        pre = hasn; }
    for (int u = bidx(); u < 8 * 47; u += gdim()) inproj_unit<2>(p, ctx_mt(u / 47), u % 47, smem);
}

DI float xsum16(float v) { v += __shfl_xor(v, 1, 64); v += __shfl_xor(v, 2, 64); v += __shfl_xor(v, 4, 64); v += __shfl_xor(v, 8, 64); return v; }
struct PrepRaw {
    unsigned qa[2], qb[2]; f32x4 cs; u32x2 sgu, sgv, cq; unsigned kvr, rk1, rk2, gate; float rc, rs; u32x2 cv[3][5];
};
DI void ph_prep(const Params& p, int l, LAS char* smem, bool dry = false) {
    (void)smem;
    const int lane = tidx() & 63, gw = bidx() * 4 + (tidx() >> 6), nw = gdim() * 4;
    const int c4 = lane * 4;
    const f32x4 sgg = *(const f32x4*)(p.sg_norm_g + l * 256 + c4), qng = *(const f32x4*)(p.mla_q_norm_g + l * 256 + c4);
    const float kvg0 = p.mla_kv_norm_g[l * 128 + lane * 2], kvg1 = p.mla_kv_norm_g[l * 128 + lane * 2 + 1];
    const int rd = 2 * (lane & 15);
    const float inv8 = exp2f(-(float)(lane & 7) * (13.287712379549449f / 8.f));
    auto load = [&](int tok, PrepRaw& r) {
        const int s = tok_s(tok); const bool isctx = s < CTXL; const int n = s - CTXL;
        const bf16_t* pr = p.P + (size_t)tok * PW;
        r.cs = (f32x4){1.f, 0.f, 1.f, 0.f};
        if (!isctx) r.cs = *(const f32x4*)(p.ROT + ((size_t)n * 32 + rd) * 2);
#pragma unroll
        for (int which = 0; which < 2; ++which) { const bf16_t* qi = pr + which * 256 + (lane >> 4) * 64 + rd; r.qa[which] = *(const unsigned*)qi; r.qb[which] = *(const unsigned*)(qi + 32); }
        r.sgu = *(const u32x2*)(pr + OFF_SG + c4); r.sgv = *(const u32x2*)(pr + OFF_SG + 256 + c4);
        r.cq = *(const u32x2*)(pr + OFF_MLA + c4); r.kvr = *(const unsigned*)(pr + OFF_MLA + 256 + lane * 2);
        r.rk1 = 0u; r.rk2 = 0u; r.gate = 0u; r.rc = 1.f; r.rs = 0.f;
        if (lane < 16 && !isctx) { const int part = lane >> 3, i = lane & 7; const float* t8 = p.ROT + (size_t)SEQ * 64 + ((part == 0 ? (n >> 6) : (n & 63)) * 8 + i) * 2; r.rc = t8[0]; r.rs = t8[1]; }
        if (lane < 16) { const int part = lane >> 3, i = lane & 7; r.rk1 = pr[OFF_MLA + 384 + part * 16 + i]; r.rk2 = pr[OFF_MLA + 384 + part * 16 + i + 8]; r.gate = pr[OFF_DNZ + 256 + lane]; }
        const int pos = isctx ? s : n, len = isctx ? CTXL : SEQ;
#pragma unroll
        for (int j = 0; j < 3; ++j)
#pragma unroll
            for (int i = 0; i < 5; ++i) { const int ps = pos + i - 2; r.cv[j][i] = (u32x2){0u, 0u};
                if (ps >= 0 && ps < len) r.cv[j][i] = *(const u32x2*)(p.DNRAW + (size_t)(tok + i - 2) * 768 + c4 + 256 * j); }
    };
    auto up = [](u32x2 r) { f32x4 o; o[0] = __uint_as_float(r[0] << 16); o[1] = __uint_as_float(r[0] & 0xffff0000u); o[2] = __uint_as_float(r[1] << 16); o[3] = __uint_as_float(r[1] & 0xffff0000u); return o; };
    PrepRaw cur, nxt;
    if (gw < NT) load(gw, cur);
    for (int tok = gw; tok < NT; tok += nw) {
        if (tok + nw < NT) load(tok + nw, nxt);
        const int b = tok_b(tok), s = tok_s(tok); const bool isctx = s < CTXL; const int n = s - CTXL;
        bf16_t* pw = dry ? p.Y + (size_t)(tok & 8191) * PW : p.P + (size_t)tok * PW;
        {
            const float c0 = cur.cs[0], s0 = cur.cs[1], c1 = cur.cs[2], s1 = cur.cs[3];
#pragma unroll
            for (int which = 0; which < 2; ++which) {
                bf16_t* q = pw + which * 256 + (lane >> 4) * 64 + rd;
                const unsigned a = cur.qa[which], bq = cur.qb[which];
                const float x10 = __uint_as_float(a << 16), x11 = __uint_as_float(a & 0xffff0000u), x20 = __uint_as_float(bq << 16), x21 = __uint_as_float(bq & 0xffff0000u);
                const float sc = which ? 0.125f : 1.f;
                *(unsigned*)q = pack2((x10 * c0 - x20 * s0) * sc, (x11 * c1 - x21 * s1) * sc);
                *(unsigned*)(q + 32) = pack2((x20 * c0 + x10 * s0) * sc, (x21 * c1 + x11 * s1) * sc);
            }
        }
        {
            const f32x4 u = up(cur.sgu), v = up(cur.sgv); f32x4 gu, gv;
#pragma unroll
            for (int j = 0; j < 4; ++j) { gu[j] = gelu_tanh(u[j]); gv[j] = gelu_tanh(v[j]); }
            const float mean = wave_sum(gv[0] + gv[1] + gv[2] + gv[3]) * (1.f / 256.f);
            f32x4 d; float vs = 0.f;
#pragma unroll
            for (int j = 0; j < 4; ++j) { d[j] = gv[j] - mean; vs += d[j] * d[j]; }
            const float rstd = rsqrtf(wave_sum(vs) * (1.f / 256.f) + EPS);
#pragma unroll
            for (int j = 0; j < 4; ++j) d[j] = d[j] * rstd * sgg[j];
            store_bf4(pw + OFF_SG + c4, gu); store_bf4(pw + OFF_SG + 256 + c4, d);
        }
        {
            f32x4 cq = up(cur.cq);
            const unsigned kvr = cur.kvr;
            float k0 = __uint_as_float(kvr << 16), k1 = __uint_as_float(kvr & 0xffff0000u);
            const float rq = rsqrtf(wave_sum(cq[0] * cq[0] + cq[1] * cq[1] + cq[2] * cq[2] + cq[3] * cq[3]) * (1.f / 256.f) + EPS);
            const float rk = rsqrtf(wave_sum(k0 * k0 + k1 * k1) * (1.f / 128.f) + EPS);
#pragma unroll
            for (int j = 0; j < 4; ++j) cq[j] = cq[j] * rq * qng[j];
            store_bf4(pw + OFF_MLA + c4, cq);
            *(unsigned*)(pw + OFF_MLA + 256 + lane * 2) = pack2(k0 * rk * kvg0, k1 * rk * kvg1);
        }
        if (lane < 16 && !dry) {
            const int part = lane >> 3, i = lane & 7;
            const float x1 = bf2f((bf16_t)cur.rk1), x2 = bf2f((bf16_t)cur.rk2); float y1 = x1, y2 = x2;
            if (!isctx) { const float cs = cur.rc, sn = cur.rs; y1 = x1 * cs - x2 * sn; y2 = x2 * cs + x1 * sn; }
#pragma unroll
            for (int hh = 0; hh < 4; ++hh) { bf16_t* kd = p.MK + (((size_t)b * 4 + hh) * SU + s) * 96 + 64 + part * 16 + i; kd[0] = f2bf(y1); kd[8] = f2bf(y2); }
        }
        if (dry) {} else if (lane < 8) { const float a = bf2f((bf16_t)cur.gate); p.DG[(size_t)tok * 8 + lane] = -expf(p.dn_A_log[l * 8 + lane]) * softplusf_(a + p.dn_dt_bias[l * 8 + lane]); }
        else if (lane < 16) { p.DB[(size_t)tok * 8 + (lane - 8)] = sigmoidf_(bf2f((bf16_t)cur.gate)); }
        {
#pragma unroll
            for (int j = 0; j < 3; ++j) {
                const int c = c4 + 256 * j; f32x4 a = (f32x4){0.f, 0.f, 0.f, 0.f};
#pragma unroll
                for (int i = 0; i < 5; ++i) { const f32x4 xv = up(cur.cv[j][i]), wv = *(const f32x4*)(p.dn_conv_w + ((size_t)l * 5 + i) * 768 + c); a += xv * wv; }
                float ssq = 0.f;
#pragma unroll
                for (int jj = 0; jj < 4; ++jj) { a[jj] = siluf(a[jj]); ssq += a[jj] * a[jj]; }
                if (j < 2) { const float sc = rsqrtf(xsum16(ssq) + EPS) * (j == 0 ? 0.125f : 1.f); a *= sc; }
                store_bf4((dry ? p.Y + (size_t)8192 * PW + (size_t)(tok & 8191) * 768 : p.DNQKV + (size_t)tok * 768) + c, a);
            }
        }
        cur = nxt;
    }
}

DI void ph_mla_up_unit(const Params& p, int u, LAS char* smem) {
    const float qscale = 0.10206207261596575f * 1.4426950408889634f;
    {
        const int mt = u / 7, j = u % 7;
        f32x4 acc[4][4]; zero_acc(acc);
        if (j < 3) {
            const bf16_t* A = p.P + (size_t)mt * 128 * PW + OFF_MLA;
            gemm_tile(acc, A, [&](int r) { return r * PW; }, p.WuqT + (size_t)j * 128 * 256, 256, 256, smem);
            for_frags(acc, [&](int r, int c, f32x4 lo, f32x4 hi) { const int tok = mt * 128 + r, col = j * 128 + c, hh = col / 96, d = col % 96;
                store_bf8(p.MQ + (((size_t)tok_b(tok) * 4 + hh) * SU + tok_s(tok)) * 96 + d, lo * qscale, hi * qscale); });
        } else {
            const int hh = j - 3;
            const bf16_t* A = p.P + (size_t)mt * 128 * PW + OFF_MLA + 256;
            gemm_tile(acc, A, [&](int r) { return r * PW; }, p.WukvT + (size_t)hh * 128 * 128, 128, 128, smem);
            for_frags(acc, [&](int r, int c, f32x4 lo, f32x4 hi) { const int tok = mt * 128 + r, b = tok_b(tok), s = tok_s(tok);
                if (c < 64) store_bf8(p.MK + (((size_t)b * 4 + hh) * SU + s) * 96 + c, lo, hi);
                else { const int sp = (s & ~15) | (s & 3) | ((s & 4) << 1) | ((s & 8) >> 1);
                    bf16_t* d = p.MVT + (((size_t)b * 4 + hh) * 64 + (c - 64)) * SU + sp;
                    d[0] = f2bf(lo[0]); d[SU] = f2bf(lo[1]); d[2 * SU] = f2bf(lo[2]); d[3 * SU] = f2bf(lo[3]); d[4 * SU] = f2bf(hi[0]); d[5 * SU] = f2bf(hi[1]); d[6 * SU] = f2bf(hi[2]); d[7 * SU] = f2bf(hi[3]); } });
        }
    }
}

DI float rdl(float v, int i) { return __int_as_float(__builtin_amdgcn_readlane(__float_as_int(v), i)); }
DI void ph_scan(const Params& p, int l) {
    const int lane = tidx() & 63, cid = bidx() * 4 + (tidx() >> 6);
    if (cid >= 64) return;
    const int kind = cid >> 5, b = (cid >> 3) & 3, hh = (cid >> 1) & 3, dir = cid & 1;
    if ((kind == 0 && RET_NEW) || (kind == 1 && DN_NEW)) return;
    float S[64];
#pragma unroll
    for (int i = 0; i < 64; ++i) S[i] = 0.f;
    const float gam = kind == 0 ? sigmoidf_(p.ret_logit[l * 8 + dir * 4 + hh]) : 0.f;
    for (int i = 0; i < SU; ++i) {
        const int s = dir == 0 ? i : (i < CTXL ? CTXL - 1 - i : SU - 1 - (i - CTXL));
        const size_t tok = (size_t)b * SU + s;
        float q, k, v, o = 0.f;
        if (kind == 0) {
            const bf16_t* pr = p.P + tok * PW + hh * 64 + lane;
            q = bf2f(pr[0]); k = bf2f(pr[256]); v = bf2f(pr[512]);
            if (dir == 0) {
#pragma unroll
                for (int d = 0; d < 64; ++d) { S[d] = gam * S[d] + rdl(k, d) * v; o += rdl(q, d) * S[d]; }
            } else {
#pragma unroll
                for (int d = 0; d < 64; ++d) { S[d] = gam * S[d]; o += rdl(q, d) * S[d]; S[d] += rdl(k, d) * v; }
            }
            p.Y[tok * DM + dir * 256 + hh * 64 + lane] = f2bf(o);
        } else {
            const bf16_t* pr = p.DNQKV + tok * 768 + hh * 64 + lane;
            q = bf2f(pr[0]); k = bf2f(pr[256]); v = bf2f(pr[512]);
            const float g = p.DG[tok * 8 + dir * 4 + hh], beta = p.DB[tok * 8 + dir * 4 + hh], eg = __expf(g);
            float kS = 0.f;
#pragma unroll
            for (int d = 0; d < 64; ++d) kS += rdl(k, d) * S[d];
            const float dd = beta * (v - eg * kS);
#pragma unroll
            for (int d = 0; d < 64; ++d) { S[d] = eg * S[d] + rdl(k, d) * dd; o += rdl(q, d) * S[d]; }
            p.Y[tok * DM + 512 + dir * 256 + hh * 64 + lane] = f2bf(o);
        }
    }
}

DI void ph_fin(const Params& p, int l) {
    const int lane = tidx() & 63, gw = bidx() * 4 + (tidx() >> 6), nw = gdim() * 4;
    for (int tok = gw; tok < NT; tok += nw) {
        bf16_t* y = p.Y + (size_t)tok * DM; const bf16_t* pr = p.P + (size_t)tok * PW;
#pragma unroll
        for (int hh = 0; hh < 4; ++hh) {
            const int c = hh * 64 + lane;
            if (!RET_NEW) { const float o = bf2f(y[c]) + bf2f(y[256 + c]); const float mean = wave_sum(o) * (1.f / 64.f), d = o - mean; const float var = wave_sum(d * d) * (1.f / 64.f);
              y[c] = f2bf(d * rsqrtf(var + EPS) * siluf(bf2f(pr[768 + c]))); }
            if (!DN_NEW) { const float o2 = bf2f(y[512 + c]) + bf2f(y[768 + c]); const float ms = wave_sum(o2 * o2) * (1.f / 64.f);
              y[512 + c] = f2bf(o2 * rsqrtf(ms + EPS) * p.dn_norm_g[l * 64 + lane] * siluf(bf2f(pr[OFF_DNZ + c]))); }
        }
    }
}

typedef float f32x2 __attribute__((ext_vector_type(2)));
DI int crow(int reg, int h) { return (reg & 3) + 8 * (reg >> 2) + 4 * h; }
DI bf16x8 pack8(const f32x16& x, int s) {
    u32x4 r; r[0] = pack2(x[8 * s + 0], x[8 * s + 1]); r[1] = pack2(x[8 * s + 2], x[8 * s + 3]); r[2] = pack2(x[8 * s + 4], x[8 * s + 5]); r[3] = pack2(x[8 * s + 6], x[8 * s + 7]);
    return __builtin_bit_cast(bf16x8, r);
}
#define MFMA32(a, b, c) __builtin_amdgcn_mfma_f32_32x32x16_bf16((a), (b), (c), 0, 0, 0)
DI float opaque_zero() { float z; asm volatile("v_mov_b32 %0, 0" : "=v"(z)); return z; }
DI f32x16 zero16() { const float z0 = opaque_zero(); f32x16 z;
#pragma unroll
    for (int i = 0; i < 16; ++i) z[i] = z0;
    return z; }
DI bf16x8 cat4(s16x4 lo, s16x4 hi) { return __builtin_shufflevector(lo, hi, 0, 1, 2, 3, 4, 5, 6, 7); }
DI void rope_q(const float* R8, bf16x8 (&Qf)[6], int n, int h2) {
#pragma unroll
    for (int f = 0; f < 2; ++f) {
        const int posi = f == 0 ? (n >> 6) : (n & 63);
        const u32x4 mine = __builtin_bit_cast(u32x4, Qf[4 + f]); u32x4 oth, res;
#pragma unroll
        for (int q = 0; q < 4; ++q) oth[q] = __shfl_xor(mine[q], 32, 64);
#pragma unroll
        for (int q = 0; q < 4; ++q) {
            const float xa = __uint_as_float(mine[q] << 16), xb = __uint_as_float(mine[q] & 0xffff0000u), ya = __uint_as_float(oth[q] << 16), yb = __uint_as_float(oth[q] & 0xffff0000u);
            const f32x4 cs4 = *(const f32x4*)(R8 + (posi * 8 + 2 * q) * 2); const float ca = cs4[0], sa = cs4[1], cb = cs4[2], sb = cs4[3];
            const float ra = h2 == 0 ? xa * ca - ya * sa : xa * ca + ya * sa, rb = h2 == 0 ? xb * cb - yb * sb : xb * cb + yb * sb;
            res[q] = pack2(ra, rb);
        }
        Qf[4 + f] = __builtin_bit_cast(bf16x8, res);
    }
}
DI float max16(const f32x16& S) {
    return fmaxf(fmaxf(fmaxf(fmaxf(S[0], S[1]), fmaxf(S[2], S[3])), fmaxf(fmaxf(S[4], S[5]), fmaxf(S[6], S[7]))), fmaxf(fmaxf(fmaxf(S[8], S[9]), fmaxf(S[10], S[11])), fmaxf(fmaxf(S[12], S[13]), fmaxf(S[14], S[15]))));
}
DI void attn_unit_classic(const Params& p, int b, int hh, int s0, int nkeys, LAS char* smem) {
    const int t = tidx(), lane = t & 63, w = t >> 6, r = lane & 31, h2 = lane >> 5;
    const bf16_t* Kb = p.MK + ((size_t)b * 4 + hh) * SU * 96;
    const bf16_t* Vb = p.MVT + ((size_t)b * 4 + hh) * 64 * SU;
    const int sqa = s0 + w * 64 + r, sqb = sqa + 32;
    bf16x8 Qa[6], Qb[6];
    { const bf16_t* q = p.MQ + (((size_t)b * 4 + hh) * SU + sqa) * 96 + 8 * h2;
#pragma unroll
      for (int st = 0; st < 6; ++st) { Qa[st] = *(const bf16x8*)(q + 16 * st); Qb[st] = *(const bf16x8*)(q + 32 * 96 + 16 * st); } }
    if (s0 >= CTXL) { rope_q(p.ROT + (size_t)SEQ * 64, Qa, sqa - CTXL, h2); rope_q(p.ROT + (size_t)SEQ * 64, Qb, sqb - CTXL, h2); }
    unsigned ko[4], vo[2];
#pragma unroll
    for (int i = 0; i < 4; ++i) { const int key = (w + 4 * i) * 4 + (lane >> 4); int part = (lane & 15) ^ (key & 15); if (part >= 12) part -= 12; ko[i] = (unsigned)(key * 96 + part * 8) * 2; }
#pragma unroll
    for (int i = 0; i < 2; ++i) { const int dv = (w + 4 * i) * 8 + (lane >> 3); const int ch = (lane & 7) ^ ((dv >> 1) & 7); vo[i] = (unsigned)(dv * SU + ch * 8) * 2; }
    const unsigned ldsw = (unsigned)__builtin_amdgcn_readfirstlane((int)((unsigned)(size_t)smem + w * 1024));
    auto stage = [&](int kt) {
        const unsigned dK = ldsw + (kt & 1) * 24576, dV = dK + 16384;
#pragma unroll
        for (int i = 0; i < 4; ++i) glds16(Kb + (size_t)kt * (64 * 96), ko[i], dK + i * 4096);
#pragma unroll
        for (int i = 0; i < 2; ++i) glds16(Vb + (size_t)kt * 64, vo[i], dV + i * 4096);
    };
    f32x16 Oa0 = zero16(), Oa1 = zero16(), Ob0 = zero16(), Ob1 = zero16();
    float ma = -1e30f, la = 0.f, mb = -1e30f, lb = 0.f;
    const int nkt = nkeys / 64;
    __syncthreads();
    stage(0);
    asm volatile("s_waitcnt vmcnt(0)" ::: "memory");
    __syncthreads();
    const int vsw0 = ((r >> 1) & 7);
    for (int kt = 0; kt < nkt; ++kt) {
        if (kt + 1 < nkt) stage(kt + 1);
        const LAS char* sK = smem + (kt & 1) * 24576; const LAS char* sV = sK + 16384;
#pragma unroll
        for (int sub = 0; sub < 2; ++sub) {
            f32x16 Sa = zero16(), Sb = zero16();
            const int key = sub * 32 + r;
#pragma unroll
            for (int st = 0; st < 6; ++st) { const bf16x8 kf = *(const LAS bf16x8*)(sK + key * 256 + (((st * 2 + h2) ^ (key & 15)) * 16)); Sa = MFMA32(kf, Qa[st], Sa); Sb = MFMA32(kf, Qb[st], Sb); }
            __builtin_amdgcn_sched_barrier(0);
            float mxa = max16(Sa), mxb = max16(Sb);
            mxa = fmaxf(mxa, __shfl_xor(mxa, 32, 64)); mxb = fmaxf(mxb, __shfl_xor(mxb, 32, 64));
            if (__any(mxa > ma + 8.f || mxb > mb + 8.f)) {
                const float na = fmaxf(ma, mxa), nb = fmaxf(mb, mxb), aa = __builtin_amdgcn_exp2f(ma - na), ab = __builtin_amdgcn_exp2f(mb - nb);
                la *= aa; ma = na; lb *= ab; mb = nb;
#pragma unroll
                for (int i = 0; i < 16; ++i) { Oa0[i] *= aa; Oa1[i] *= aa; Ob0[i] *= ab; Ob1[i] *= ab; }
            }
            float pa = 0.f, pbs = 0.f;
#pragma unroll
            for (int i = 0; i < 16; ++i) { Sa[i] = __builtin_amdgcn_exp2f(Sa[i] - ma); Sb[i] = __builtin_amdgcn_exp2f(Sb[i] - mb); pa += Sa[i]; pbs += Sb[i]; }
            la += pa; lb += pbs;
            __builtin_amdgcn_sched_barrier(0);
#pragma unroll
            for (int s2 = 0; s2 < 2; ++s2) {
                const bf16x8 qa = pack8(Sa, s2), qb = pack8(Sb, s2);
                const int c = sub * 4 + 2 * s2;
                const bf16x8 v0 = *(const LAS bf16x8*)(sV + r * 128 + (((c + h2) ^ vsw0) * 16)), v1 = *(const LAS bf16x8*)(sV + (32 + r) * 128 + (((c + h2) ^ vsw0) * 16));
                Oa0 = MFMA32(v0, qa, Oa0); Ob0 = MFMA32(v0, qb, Ob0); Oa1 = MFMA32(v1, qa, Oa1); Ob1 = MFMA32(v1, qb, Ob1);
            }
            __builtin_amdgcn_sched_barrier(0);
        }
        asm volatile("s_waitcnt vmcnt(0)" ::: "memory");
        __syncthreads();
    }
    la += __shfl_xor(la, 32, 64); lb += __shfl_xor(lb, 32, 64);
    const float ia = 1.f / la, ib = 1.f / lb;
    bf16_t* ya = p.Y + ((size_t)b * SU + sqa) * DM + 768 + hh * 64; bf16_t* yb = ya + (size_t)32 * DM;
#pragma unroll
    for (int g = 0; g < 4; ++g) {
        store_bf4(ya + 8 * g + 4 * h2, (f32x4){Oa0[4 * g] * ia, Oa0[4 * g + 1] * ia, Oa0[4 * g + 2] * ia, Oa0[4 * g + 3] * ia});
        store_bf4(ya + 32 + 8 * g + 4 * h2, (f32x4){Oa1[4 * g] * ia, Oa1[4 * g + 1] * ia, Oa1[4 * g + 2] * ia, Oa1[4 * g + 3] * ia});
        store_bf4(yb + 8 * g + 4 * h2, (f32x4){Ob0[4 * g] * ib, Ob0[4 * g + 1] * ib, Ob0[4 * g + 2] * ib, Ob0[4 * g + 3] * ib});
        store_bf4(yb + 32 + 8 * g + 4 * h2, (f32x4){Ob1[4 * g] * ib, Ob1[4 * g + 1] * ib, Ob1[4 * g + 2] * ib, Ob1[4 * g + 3] * ib});
    }
}

DI bool attn_unit(const Params& p, int b, int hh, int s0, int nkeys, LAS char* smem) {
    const int t = tidx(), lane = t & 63, w = t >> 6, r = lane & 31, h2 = lane >> 5;
    const bf16_t* Kb = p.MK + ((size_t)b * 4 + hh) * SU * 96;
    const bf16_t* Vb = p.MVT + ((size_t)b * 4 + hh) * 64 * SU;
    const int sqa = s0 + w * 64 + r, sqb = sqa + 32;
    bf16x8 Qa[6], Qb[6];
    { const bf16_t* q = p.MQ + (((size_t)b * 4 + hh) * SU + sqa) * 96 + 8 * h2;
#pragma unroll
      for (int st = 0; st < 6; ++st) { Qa[st] = *(const bf16x8*)(q + 16 * st); Qb[st] = *(const bf16x8*)(q + 32 * 96 + 16 * st); } }
    if (s0 >= CTXL) { rope_q(p.ROT + (size_t)SEQ * 64, Qa, sqa - CTXL, h2); rope_q(p.ROT + (size_t)SEQ * 64, Qb, sqb - CTXL, h2); }
    unsigned ko[4], vo[2];
#pragma unroll
    for (int i = 0; i < 4; ++i) { const int key = (w + 4 * i) * 4 + (lane >> 4); int part = (lane & 15) ^ (key & 15); if (part >= 12) part -= 12; ko[i] = (unsigned)(key * 96 + part * 8) * 2; }
#pragma unroll
    for (int i = 0; i < 2; ++i) { const int dv = (w + 4 * i) * 8 + (lane >> 3); const int ch = (lane & 7) ^ ((dv >> 1) & 7); vo[i] = (unsigned)(dv * SU + ch * 8) * 2; }
    const unsigned ldsw = (unsigned)__builtin_amdgcn_readfirstlane((int)((unsigned)(size_t)smem + w * 1024));
    auto stage = [&](int kt) {
        const unsigned dK = ldsw + (kt & 1) * 24576, dV = dK + 16384;
#pragma unroll
        for (int i = 0; i < 4; ++i) glds16(Kb + (size_t)kt * (64 * 96), ko[i], dK + i * 4096);
#pragma unroll
        for (int i = 0; i < 2; ++i) glds16(Vb + (size_t)kt * 64, vo[i], dV + i * 4096);
    };
    f32x16 Oa0 = zero16(), Oa1 = zero16(), Ob0 = zero16(), Ob1 = zero16();
    f32x2 la2 = {0.f, 0.f}, lb2 = {0.f, 0.f};
    f32x16 ZT = zero16();
    const int nkt = nkeys / 64;
    __syncthreads();
    stage(0);
    asm volatile("s_waitcnt vmcnt(0)" ::: "memory");
    __syncthreads();
    const int vsw0 = ((r >> 1) & 7);
    for (int kt = 0; kt < nkt; ++kt) {
        if (kt + 1 < nkt) stage(kt + 1);
        const LAS char* sK = smem + (kt & 1) * 24576; const LAS char* sV = sK + 16384;
#pragma unroll
        for (int sub = 0; sub < 2; ++sub) {
            f32x16 Sa, Sb;
            const int key = sub * 32 + r;
            {
                const bf16x8 kf = *(const LAS bf16x8*)(sK + key * 256 + ((h2 ^ (key & 15)) * 16));
                Sa = MFMA32(kf, Qa[0], ZT); Sb = MFMA32(kf, Qb[0], ZT);
            }
#pragma unroll
            for (int st = 1; st < 6; ++st) { const bf16x8 kf = *(const LAS bf16x8*)(sK + key * 256 + (((st * 2 + h2) ^ (key & 15)) * 16)); Sa = MFMA32(kf, Qa[st], Sa); Sb = MFMA32(kf, Qb[st], Sb); }
            __builtin_amdgcn_sched_barrier(0);
#pragma unroll
            for (int i = 0; i < 8; ++i) {
                Sa[2 * i] = __builtin_amdgcn_exp2f(Sa[2 * i]); Sa[2 * i + 1] = __builtin_amdgcn_exp2f(Sa[2 * i + 1]); Sb[2 * i] = __builtin_amdgcn_exp2f(Sb[2 * i]); Sb[2 * i + 1] = __builtin_amdgcn_exp2f(Sb[2 * i + 1]);
                la2 += (f32x2){Sa[2 * i], Sa[2 * i + 1]}; lb2 += (f32x2){Sb[2 * i], Sb[2 * i + 1]};
            }
            __builtin_amdgcn_sched_barrier(0);
#pragma unroll
            for (int s2 = 0; s2 < 2; ++s2) {
                const bf16x8 qa = pack8(Sa, s2), qb = pack8(Sb, s2);
                const int c = sub * 4 + 2 * s2;
                const bf16x8 v0 = *(const LAS bf16x8*)(sV + r * 128 + (((c + h2) ^ vsw0) * 16)), v1 = *(const LAS bf16x8*)(sV + (32 + r) * 128 + (((c + h2) ^ vsw0) * 16));
                Oa0 = MFMA32(v0, qa, Oa0); Ob0 = MFMA32(v0, qb, Ob0); Oa1 = MFMA32(v1, qa, Oa1); Ob1 = MFMA32(v1, qb, Ob1);
            }
            __builtin_amdgcn_sched_barrier(0);
        }
        asm volatile("s_waitcnt vmcnt(0)" ::: "memory");
        __syncthreads();
    }
    float la = la2[0] + la2[1], lb = lb2[0] + lb2[1];
    la += __shfl_xor(la, 32, 64); lb += __shfl_xor(lb, 32, 64);
    bool bad = !(la > 1e-30f) || !(la < 1e33f) || !(lb > 1e-30f) || !(lb < 1e33f);
    const float ia = 1.f / la, ib = 1.f / lb;
    { float ca = 0.f, cb = 0.f;
#pragma unroll
      for (int i = 0; i < 16; ++i) { ca = fmaxf(ca, fmaxf(fabsf(Oa0[i]), fabsf(Oa1[i]))); cb = fmaxf(cb, fmaxf(fabsf(Ob0[i]), fabsf(Ob1[i]))); }
      bad = bad || !(ca * ia < 1e30f) || !(cb * ib < 1e30f); }
    {
        LAS int* flags = (LAS int*)(smem + 49152);
        const bool wbad = __any(bad);
        if (lane == 0) flags[w] = wbad ? 1 : 0;
        __syncthreads();
        if (__builtin_amdgcn_readfirstlane(flags[0] | flags[1] | flags[2] | flags[3])) return true;
    }
    bf16_t* ya = p.Y + ((size_t)b * SU + sqa) * DM + 768 + hh * 64; bf16_t* yb = ya + (size_t)32 * DM;
#pragma unroll
    for (int g = 0; g < 4; ++g) {
        store_bf4(ya + 8 * g + 4 * h2, (f32x4){Oa0[4 * g] * ia, Oa0[4 * g + 1] * ia, Oa0[4 * g + 2] * ia, Oa0[4 * g + 3] * ia});
        store_bf4(ya + 32 + 8 * g + 4 * h2, (f32x4){Oa1[4 * g] * ia, Oa1[4 * g + 1] * ia, Oa1[4 * g + 2] * ia, Oa1[4 * g + 3] * ia});
        store_bf4(yb + 8 * g + 4 * h2, (f32x4){Ob0[4 * g] * ib, Ob0[4 * g + 1] * ib, Ob0[4 * g + 2] * ib, Ob0[4 * g + 3] * ib});
        store_bf4(yb + 32 + 8 * g + 4 * h2, (f32x4){Ob1[4 * g] * ib, Ob1[4 * g + 1] * ib, Ob1[4 * g + 2] * ib, Ob1[4 * g + 3] * ib});
    }
    return false;
}

constexpr int IMG = 136;
DI void sgm_unit(const Params& p, int l, int b, int c, int g, LAS char* smem) {
    LAS bf16_t* VT = (LAS bf16_t*)smem;
    const int t = tidx(), lane = t & 63, w = t >> 6, r = lane & 31, h2 = lane >> 5;
    const size_t tok0 = (size_t)b * SU + c * 128;
    __syncthreads();
    { const int j = t >> 1, half = t & 1; const bf16_t* vr = p.P + (tok0 + j) * PW + OFF_SG + 256 + g * 64 + half * 32;
#pragma unroll
      for (int q4 = 0; q4 < 4; ++q4) { const bf16x8 vv = *(const bf16x8*)(vr + q4 * 8);
#pragma unroll
          for (int e = 0; e < 8; ++e) VT[(half * 32 + q4 * 8 + e) * IMG + j] = (bf16_t)vv[e]; } }
    const int i = 32 * w + r;
    const bf16_t* wrow = p.SGW + ((size_t)g * 128 + i) * 128 + 8 * h2;
    bf16x8 Wf[8];
#pragma unroll
    for (int s8 = 0; s8 < 8; ++s8) Wf[s8] = *(const bf16x8*)(wrow + 16 * s8);
    __syncthreads();
    f32x16 O0 = zero16(), O1 = zero16();
#pragma unroll
    for (int s8 = 0; s8 < 8; ++s8) {
        O0 = MFMA32(*(const LAS bf16x8*)(VT + r * IMG + 16 * s8 + 8 * h2), Wf[s8], O0);
        O1 = MFMA32(*(const LAS bf16x8*)(VT + (32 + r) * IMG + 16 * s8 + 8 * h2), Wf[s8], O1);
    }
    const float bias = p.sg_b[((size_t)l * 4 + g) * 128 + i];
    const bf16_t* ur = p.P + (tok0 + i) * PW + OFF_SG + g * 64 + 4 * h2; bf16_t* y = p.Y + (tok0 + i) * DM + 256 + g * 64 + 4 * h2;
#pragma unroll
    for (int q = 0; q < 4; ++q) {
        const f32x4 u0 = ld_bf4(ur + 8 * q), u1 = ld_bf4(ur + 32 + 8 * q); f32x4 o0, o1;
#pragma unroll
        for (int j = 0; j < 4; ++j) { o0[j] = u0[j] * (O0[4 * q + j] + bias); o1[j] = u1[j] * (O1[4 * q + j] + bias); }
        store_bf4(y + 8 * q, o0); store_bf4(y + 32 + 8 * q, o1);
    }
}

DI size_t st_slot(int b, int h, int dir, int c) { return ((size_t)(((b * 4 + h) * 2 + dir) * NCHUNK + c)) * 4096; }
DI int chunk_of(int dir, int step) { return dir == 0 ? step : (step < 2 ? 1 - step : NCHUNK + 1 - step); }
DI float ret_lg2(const Params& p, int l, int dir, int h) { return -log1pf(expf(-p.ret_logit[l * 8 + dir * 4 + h])) * 1.4426950408889634f; }

DI void retkv_unit(const Params& p, int l, int b, int h, int c, LAS char* smem) {
    LAS bf16_t* KTf = (LAS bf16_t*)smem; LAS bf16_t* KTb = KTf + 64 * IMG; LAS bf16_t* VT = KTb + 64 * IMG;
    const int t = tidx(), lane = t & 63, w = t >> 6, r = lane & 31, h2 = lane >> 5;
    const size_t tok0 = (size_t)b * SU + c * 128;
    const float lgf = ret_lg2(p, l, 0, h), lgb = ret_lg2(p, l, 1, h);
    __syncthreads();
    { const int j = t >> 1, half = t & 1;
      const bf16_t* kr = p.P + (tok0 + j) * PW + 256 + h * 64 + half * 32; const bf16_t* vr = kr + 256;
      const float wf = exp2f((float)(127 - j) * lgf), wb = exp2f((float)j * lgb);
#pragma unroll
      for (int q4 = 0; q4 < 4; ++q4) { const bf16x8 kk = *(const bf16x8*)(kr + q4 * 8), vv = *(const bf16x8*)(vr + q4 * 8);
#pragma unroll
          for (int e = 0; e < 8; ++e) { const int d = half * 32 + q4 * 8 + e; const float kv = bf2f((bf16_t)kk[e]);
              KTf[d * IMG + j] = f2bf(kv * wf); KTb[d * IMG + j] = f2bf(kv * wb); VT[d * IMG + j] = (bf16_t)vv[e]; } } }
    __syncthreads();
    const int dkt = w >> 1, dvt = w & 1;
    f32x16 af = zero16(), ab = zero16();
#pragma unroll
    for (int s = 0; s < 8; ++s) {
        const bf16x8 a_f = *(const LAS bf16x8*)(KTf + (dkt * 32 + r) * IMG + 16 * s + 8 * h2), a_b = *(const LAS bf16x8*)(KTb + (dkt * 32 + r) * IMG + 16 * s + 8 * h2);
        const bf16x8 bv = *(const LAS bf16x8*)(VT + (dvt * 32 + r) * IMG + 16 * s + 8 * h2);
        af = MFMA32(a_f, bv, af); ab = MFMA32(a_b, bv, ab);
    }
    bf16_t* of = p.RS + st_slot(b, h, 0, c) + (dvt * 32 + r) * 64 + dkt * 32 + 4 * h2;
    bf16_t* ob = p.RS + st_slot(b, h, 1, c) + (dvt * 32 + r) * 64 + dkt * 32 + 4 * h2;
#pragma unroll
    for (int g = 0; g < 4; ++g) { store_bf4(of + 8 * g, (f32x4){af[4 * g], af[4 * g + 1], af[4 * g + 2], af[4 * g + 3]}); store_bf4(ob + 8 * g, (f32x4){ab[4 * g], ab[4 * g + 1], ab[4 * g + 2], ab[4 * g + 3]}); }
}

DI void ret_scan(const Params& p, int l, int gid) {
    const int ch = gid >> 11, e2 = gid & 2047, dir = ch & 1, h = (ch >> 1) & 3;
    const float gc = exp2f(128.f * ret_lg2(p, l, dir, h));
    unsigned* base = (unsigned*)(p.RS + (size_t)ch * NCHUNK * 4096) + e2;
    float s0 = 0.f, s1 = 0.f;
#pragma unroll 1
    for (int g = 0; g < NCHUNK / 11; ++g) {
        unsigned v[11];
#pragma unroll
        for (int s = 0; s < 11; ++s) v[s] = base[(size_t)chunk_of(dir, g * 11 + s) * 2048];
#pragma unroll
        for (int s = 0; s < 11; ++s) {
            base[(size_t)chunk_of(dir, g * 11 + s) * 2048] = pack2(s0, s1);
            s0 = gc * s0 + __uint_as_float(v[s] << 16); s1 = gc * s1 + __uint_as_float(v[s] & 0xffff0000u);
        }
    }
}

DI void retout_unit(const Params& p, int l, int b, int h, int c, LAS char* smem) {
    LAS char* sK = smem;
    LAS bf16_t* VT = (LAS bf16_t*)(smem + 128 * 144);
    const int t = tidx(), lane = t & 63, w = t >> 6, r = lane & 31, h2 = lane >> 5;
    const size_t tok0 = (size_t)b * SU + c * 128;
    const float lgf = ret_lg2(p, l, 0, h), lgb = ret_lg2(p, l, 1, h);
    __syncthreads();
    { const int j = t >> 1, half = t & 1;
      const bf16_t* kr = p.P + (tok0 + j) * PW + 256 + h * 64 + half * 32; const bf16_t* vr = kr + 256;
#pragma unroll
      for (int q4 = 0; q4 < 4; ++q4) { const bf16x8 kk = *(const bf16x8*)(kr + q4 * 8), vv = *(const bf16x8*)(vr + q4 * 8);
          *(LAS bf16x8*)(sK + j * 144 + (half * 32 + q4 * 8) * 2) = kk;
#pragma unroll
          for (int e = 0; e < 8; ++e) VT[(half * 32 + q4 * 8 + e) * IMG + j] = (bf16_t)vv[e]; } }
    const int i = 32 * w + r;
    const size_t tok = tok0 + i;
    bf16x8 Qf[4];
    { const bf16_t* qrow = p.P + tok * PW + h * 64 + 8 * h2;
#pragma unroll
      for (int st = 0; st < 4; ++st) Qf[st] = *(const bf16x8*)(qrow + 16 * st); }
    __syncthreads();
    f32x16 O0 = zero16(), O1 = zero16();
#pragma unroll
    for (int jb = 0; jb < 4; ++jb) {
        f32x16 S = zero16();
#pragma unroll
        for (int st = 0; st < 4; ++st) { const bf16x8 kf = *(const LAS bf16x8*)(sK + (jb * 32 + r) * 144 + st * 32 + h2 * 16); S = MFMA32(kf, Qf[st], S); }
#pragma unroll
        for (int q = 0; q < 16; ++q) { const int j = jb * 32 + crow(q, h2); const float e = (j <= i) ? (float)(i - j) * lgf : (float)(j - i) * lgb; S[q] *= __builtin_amdgcn_exp2f(e); }
#pragma unroll
        for (int s2 = 0; s2 < 2; ++s2) {
            const bf16x8 pb = pack8(S, s2); const int ko = jb * 32 + 16 * s2 + 4 * h2;
            O0 = MFMA32(cat4(*(const LAS s16x4*)(VT + r * IMG + ko), *(const LAS s16x4*)(VT + r * IMG + ko + 8)), pb, O0);
            O1 = MFMA32(cat4(*(const LAS s16x4*)(VT + (32 + r) * IMG + ko), *(const LAS s16x4*)(VT + (32 + r) * IMG + ko + 8)), pb, O1);
        }
    }
    {
        const bf16_t* Sf = p.RS + st_slot(b, h, 0, c) + 8 * h2; const bf16_t* Sb = p.RS + st_slot(b, h, 1, c) + 8 * h2;
        f32x16 T0 = zero16(), T1 = zero16(), U0 = zero16(), U1 = zero16();
#pragma unroll
        for (int st = 0; st < 4; ++st) {
            T0 = MFMA32(*(const bf16x8*)(Sf + r * 64 + 16 * st), Qf[st], T0); T1 = MFMA32(*(const bf16x8*)(Sf + (32 + r) * 64 + 16 * st), Qf[st], T1);
            U0 = MFMA32(*(const bf16x8*)(Sb + r * 64 + 16 * st), Qf[st], U0); U1 = MFMA32(*(const bf16x8*)(Sb + (32 + r) * 64 + 16 * st), Qf[st], U1);
        }
        const float df = exp2f((float)(i + 1) * lgf), db = exp2f((float)(128 - i) * lgb);
#pragma unroll
        for (int q = 0; q < 16; ++q) { O0[q] += df * T0[q] + db * U0[q]; O1[q] += df * T1[q] + db * U1[q]; }
    }
    float sm = 0.f;
#pragma unroll
    for (int q = 0; q < 16; ++q) sm += O0[q] + O1[q];
    sm += __shfl_xor(sm, 32, 64); const float mean = sm * (1.f / 64.f);
    float vs = 0.f;
#pragma unroll
    for (int q = 0; q < 16; ++q) { const float d0 = O0[q] - mean, d1 = O1[q] - mean; vs += d0 * d0 + d1 * d1; }
    vs += __shfl_xor(vs, 32, 64); const float rstd = rsqrtf(vs * (1.f / 64.f) + EPS);
    const bf16_t* gr = p.P + tok * PW + 768 + h * 64 + 4 * h2; bf16_t* y = p.Y + tok * DM + h * 64 + 4 * h2;
#pragma unroll
    for (int g = 0; g < 4; ++g) {
        const f32x4 g0 = ld_bf4(gr + 8 * g), g1 = ld_bf4(gr + 32 + 8 * g); f32x4 o0, o1;
#pragma unroll
        for (int j = 0; j < 4; ++j) { o0[j] = (O0[4 * g + j] - mean) * rstd * siluf(g0[j]); o1[j] = (O1[4 * g + j] - mean) * rstd * siluf(g1[j]); }
        store_bf4(y + 8 * g, o0); store_bf4(y + 32 + 8 * g, o1);
    }
}

DI bf16_t* qeol(const Params& p, int l) { return l == 0 ? (bf16_t*)p.out : p.H; }
DI void dnloc_unit(const Params& p, int l, int b, int h, int dir, int c, LAS char* smem) {
    LAS bf16_t* KT = (LAS bf16_t*)smem;
    LAS bf16_t* VT = KT + 64 * IMG;
    LAS bf16_t* LD = VT + 64 * IMG;
    LAS bf16_t* DI_ = LD;
    LAS float* fG = (LAS float*)(LD + 4 * 32 * 40);
    LAS float* fB = fG + 128;
    LAS float* fCW = fB + 128;
    LAS float* fDL = fCW + 128;
    LAS float* fTot = fDL + 128;
    LAS char* sKr = (LAS char*)(fTot + 4);
    const int t = tidx(), lane = t & 63, w = t >> 6, r = lane & 31, h2 = lane >> 5;
    const size_t tok0 = (size_t)b * SU + c * 128;
    auto tokof = [&](int a) { return tok0 + (dir ? 127 - a : a); };
    __syncthreads();
    float Gv = 0.f, bv = 0.f;
    if (t < 128) { const size_t tk = tokof(t); Gv = p.DG[tk * 8 + dir * 4 + h]; bv = p.DB[tk * 8 + dir * 4 + h];
#pragma unroll
        for (int off = 1; off < 64; off <<= 1) { const float n = __shfl_up(Gv, off, 64); if (lane >= off) Gv += n; }
        if (t == 63) fTot[0] = Gv; }
    { const int a = t >> 1, half = t & 1; const bf16_t* row = p.DNQKV + tokof(a) * 768 + h * 64 + half * 32;
#pragma unroll
      for (int q4 = 0; q4 < 4; ++q4) { const bf16x8 kk = *(const bf16x8*)(row + 256 + q4 * 8), vv = *(const bf16x8*)(row + 512 + q4 * 8);
          *(LAS bf16x8*)(sKr + a * 144 + (half * 32 + q4 * 8) * 2) = kk;
#pragma unroll
          for (int e = 0; e < 8; ++e) { const int d = half * 32 + q4 * 8 + e; KT[d * IMG + a] = (bf16_t)kk[e]; VT[d * IMG + a] = (bf16_t)vv[e]; } } }
    auto Kf = [&](int bl, int st) { return *(const LAS bf16x8*)(sKr + (bl * 32 + r) * 144 + st * 32 + h2 * 16); };
    __syncthreads();
    if (t >= 64 && t < 128) Gv += fTot[0];
    if (t < 128) { fG[t] = Gv; fB[t] = bv; }
    __syncthreads();
    const float Glast = fG[127];
    if (t < 128) { fCW[t] = bv * __expf(Gv); fDL[t] = __expf(Glast - Gv); }
    {
        f32x16 D = zero16();
#pragma unroll
        for (int st = 0; st < 4; ++st) { const bf16x8 kf = Kf(w, st); D = MFMA32(kf, kf, D); }
        const float Ga = fG[32 * w + r], ba = fB[32 * w + r];
#pragma unroll
        for (int g = 0; g < 4; ++g) { const f32x4 Gp = *(const LAS f32x4*)(fG + 32 * w + 8 * g + 4 * h2); f32x4 o;
#pragma unroll
            for (int j = 0; j < 4; ++j) { const int ap = 8 * g + 4 * h2 + j; o[j] = (ap < r) ? ba * __expf(fminf(Ga - Gp[j], 0.f)) * D[4 * g + j] : 0.f; }
            u32x2 pk; pk[0] = pack2(o[0], o[1]); pk[1] = pack2(o[2], o[3]); *(LAS u32x2*)(LD + (w * 32 + r) * 40 + 8 * g + 4 * h2) = pk; }
    }
    __syncthreads();
    if (t < 128) {
        const int I = t >> 5, cc = t & 31; const LAS bf16_t* Lb = LD + I * 32 * 40;
        float x[32];
#pragma unroll
        for (int i = 0; i < 32; ++i) {
            float a = (i == cc) ? 1.f : 0.f;
#pragma unroll
            for (int jc = 0; jc * 4 < i; ++jc) { const u32x2 raw = *(const LAS u32x2*)(Lb + i * 40 + jc * 4);
                const float l0 = __uint_as_float(raw[0] << 16), l1 = __uint_as_float(raw[0] & 0xffff0000u), l2 = __uint_as_float(raw[1] << 16), l3 = __uint_as_float(raw[1] & 0xffff0000u);
                if (jc * 4 + 0 < i) a -= l0 * x[jc * 4 + 0];
                if (jc * 4 + 1 < i) a -= l1 * x[jc * 4 + 1];
                if (jc * 4 + 2 < i) a -= l2 * x[jc * 4 + 2];
                if (jc * 4 + 3 < i) a -= l3 * x[jc * 4 + 3]; }
            x[i] = a;
            DI_[(I * 32 + i) * 40 + cc] = f2bf(a);
        }
    }
    __syncthreads();
    const bool isW = w >= 2; const int cbase = (w & 1) * 32, col = cbase + r;
    const LAS bf16_t* IMGX = isW ? KT : VT; const LAS float* coef = isW ? fCW : fB;
    bf16x8 PX[4][2];
    f32x16 MN0 = zero16(), MN1 = zero16();
#pragma unroll
    for (int I = 0; I < 4; ++I) {
        f32x16 acc;
#pragma unroll
        for (int g = 0; g < 4; ++g) { const int a0 = 32 * I + 8 * g + 4 * h2; const s16x4 im = *(const LAS s16x4*)(IMGX + col * IMG + a0); const f32x4 cf = *(const LAS f32x4*)(coef + a0);
#pragma unroll
            for (int j = 0; j < 4; ++j) acc[4 * g + j] = bf2f((bf16_t)im[j]) * cf[j]; }
        const float Ga = fG[32 * I + r], ba = fB[32 * I + r];
#pragma unroll
        for (int J = 0; J < I; ++J) {
            f32x16 Lt = zero16();
#pragma unroll
            for (int st = 0; st < 4; ++st) Lt = MFMA32(Kf(J, st), Kf(I, st), Lt);
#pragma unroll
            for (int g = 0; g < 4; ++g) { const f32x4 Gp = *(const LAS f32x4*)(fG + 32 * J + 8 * g + 4 * h2);
#pragma unroll
                for (int j = 0; j < 4; ++j) Lt[4 * g + j] *= -ba * __expf(fminf(Ga - Gp[j], 0.f)); }
            acc = MFMA32(pack8(Lt, 0), PX[J][0], acc); acc = MFMA32(pack8(Lt, 1), PX[J][1], acc);
        }
        f32x16 X = zero16();
#pragma unroll
        for (int s2 = 0; s2 < 2; ++s2) { const LAS bf16_t* dr = DI_ + (I * 32 + r) * 40 + 16 * s2 + 4 * h2;
            X = MFMA32(cat4(*(const LAS s16x4*)dr, *(const LAS s16x4*)(dr + 8)), pack8(acc, s2), X); }
        PX[I][0] = pack8(X, 0); PX[I][1] = pack8(X, 1);
#pragma unroll
        for (int g = 0; g < 4; ++g) { const f32x4 dl = *(const LAS f32x4*)(fDL + 32 * I + 8 * g + 4 * h2);
#pragma unroll
            for (int j = 0; j < 4; ++j) X[4 * g + j] *= dl[j]; }
#pragma unroll
        for (int s2 = 0; s2 < 2; ++s2) { const bf16x8 px = pack8(X, s2); const int ka = 32 * I + 16 * s2 + 4 * h2;
            const bf16x8 kt0 = cat4(*(const LAS s16x4*)(KT + r * IMG + ka), *(const LAS s16x4*)(KT + r * IMG + ka + 8));
            const bf16x8 kt1 = cat4(*(const LAS s16x4*)(KT + (32 + r) * IMG + ka), *(const LAS s16x4*)(KT + (32 + r) * IMG + ka + 8));
            if (isW) { MN0 = MFMA32(px, kt0, MN0); MN1 = MFMA32(px, kt1, MN1); } else { MN0 = MFMA32(kt0, px, MN0); MN1 = MFMA32(kt1, px, MN1); } }
    }
    {
        const size_t slot = st_slot(b, h, dir, c);
        if (isW) {
            const float eg = __expf(Glast);
#pragma unroll
            for (int g = 0; g < 4; ++g) { f32x4 m0, m1;
#pragma unroll
                for (int j = 0; j < 4; ++j) { const int dp = cbase + 8 * g + 4 * h2 + j; m0[j] = (dp == r ? eg : 0.f) - MN0[4 * g + j]; m1[j] = (dp == 32 + r ? eg : 0.f) - MN1[4 * g + j]; }
                store_bf4(p.DNM + slot + r * 64 + cbase + 8 * g + 4 * h2, m0); store_bf4(p.DNM + slot + (32 + r) * 64 + cbase + 8 * g + 4 * h2, m1); }
        } else {
#pragma unroll
            for (int g = 0; g < 4; ++g) { store_bf4(p.DNN + slot + col * 64 + 8 * g + 4 * h2, (f32x4){MN0[4 * g], MN0[4 * g + 1], MN0[4 * g + 2], MN0[4 * g + 3]});
                store_bf4(p.DNN + slot + col * 64 + 32 + 8 * g + 4 * h2, (f32x4){MN1[4 * g], MN1[4 * g + 1], MN1[4 * g + 2], MN1[4 * g + 3]}); }
        }
    }
    bf16_t* QE = qeol(p, l) + (size_t)dir * NT * 256; bf16_t* OL = qeol(p, l) + (size_t)(2 + dir) * NT * 256;
    LAS char* sQ = (LAS char*)VT;
    __syncthreads();
    { const int a = t >> 1, half = t & 1; const bf16_t* row = p.DNQKV + tokof(a) * 768 + h * 64 + half * 32;
#pragma unroll
      for (int q4 = 0; q4 < 4; ++q4) *(LAS bf16x8*)(sQ + a * 144 + (half * 32 + q4 * 8) * 2) = *(const bf16x8*)(row + q4 * 8); }
    __syncthreads();
#pragma unroll
    for (int I = 0; I < 4; ++I) {
        const size_t tk = tokof(32 * I + r);
        bf16x8 Qf[4];
#pragma unroll
        for (int st = 0; st < 4; ++st) Qf[st] = *(const LAS bf16x8*)(sQ + (32 * I + r) * 144 + st * 32 + h2 * 16);
        const float Ga = fG[32 * I + r];
        f32x16 out = zero16();
#pragma unroll
        for (int J = 0; J <= I; ++J) {
            f32x16 At = zero16();
#pragma unroll
            for (int st = 0; st < 4; ++st) At = MFMA32(Kf(J, st), Qf[st], At);
#pragma unroll
            for (int g = 0; g < 4; ++g) { const f32x4 Gp = *(const LAS f32x4*)(fG + 32 * J + 8 * g + 4 * h2);
#pragma unroll
                for (int j = 0; j < 4; ++j) { const int ap = 8 * g + 4 * h2 + j; const float e = __expf(fminf(Ga - Gp[j], 0.f)); At[4 * g + j] = (J < I || ap <= r) ? e * At[4 * g + j] : 0.f; } }
            out = MFMA32(PX[J][0], pack8(At, 0), out); out = MFMA32(PX[J][1], pack8(At, 1), out);
        }
        if (!isW) {
#pragma unroll
            for (int g = 0; g < 4; ++g) store_bf4(OL + tk * 256 + h * 64 + cbase + 8 * g + 4 * h2, (f32x4){out[4 * g], out[4 * g + 1], out[4 * g + 2], out[4 * g + 3]});
        } else {
            const float ega = __expf(Ga);
#pragma unroll
            for (int g = 0; g < 4; ++g) { const u32x2 raw = *(const LAS u32x2*)(sQ + (32 * I + r) * 144 + (cbase + 8 * g + 4 * h2) * 2);
                f32x4 qv; qv[0] = __uint_as_float(raw[0] << 16); qv[1] = __uint_as_float(raw[0] & 0xffff0000u); qv[2] = __uint_as_float(raw[1] << 16); qv[3] = __uint_as_float(raw[1] & 0xffff0000u);
                f32x4 o;
#pragma unroll
                for (int j = 0; j < 4; ++j) o[j] = ega * qv[j] - out[4 * g + j];
                store_bf4(QE + tk * 256 + h * 64 + cbase + 8 * g + 4 * h2, o); }
        }
    }
}

DI void dn_scan(const Params& p, int ch, LAS char* smem) {
    const int t = tidx(), lane = t & 63, vg = t >> 6, fr = lane & 15, fq = lane >> 4, dir = ch & 1;
    const size_t cbase = (size_t)ch * NCHUNK * 4096;
    f32x4 acc[4];
#pragma unroll
    for (int mt = 0; mt < 4; ++mt) acc[mt] = (f32x4){0.f, 0.f, 0.f, 0.f};
    constexpr int D = 8;
    u32x4 mq[D][2]; u32x2 nq[D][4];
    const int mrow = lane >> 3, mch = lane & 7;
    auto issue = [&](int step, u32x4 (&m)[2], u32x2 (&n)[4]) {
        const size_t so = cbase + (size_t)chunk_of(dir, step) * 4096;
        const bf16_t* M = p.DNM + so + (size_t)(16 * vg + mrow) * 64 + mch * 8; const bf16_t* N = p.DNN + so + (vg * 16 + fr) * 64 + 4 * fq;
        m[0] = *(const u32x4*)M; m[1] = *(const u32x4*)(M + 8 * 64);
#pragma unroll
        for (int mt = 0; mt < 4; ++mt) n[mt] = *(const u32x2*)(N + 16 * mt);
    };
#pragma unroll
    for (int j = 0; j < D; ++j) issue(j, mq[j], nq[j]);
    __syncthreads();
    for (int base = 0; base < NCHUNK; base += D) {
#pragma unroll
        for (int j = 0; j < D; ++j) {
            const int step = base + j;
            if (step < NCHUNK) {
                LAS char* slot = smem + (step & 1) * 8192;
                {
                    const int r0 = 16 * vg + mrow, r1 = r0 + 8;
                    *(LAS u32x4*)(slot + r0 * 128 + ((mch ^ (r0 & 7)) * 16)) = mq[j][0];
                    *(LAS u32x4*)(slot + r1 * 128 + ((mch ^ (r1 & 7)) * 16)) = mq[j][1];
                }
                f32x4 n4[4];
#pragma unroll
                for (int mt = 0; mt < 4; ++mt) { n4[mt][0] = __uint_as_float(nq[j][mt][0] << 16); n4[mt][1] = __uint_as_float(nq[j][mt][0] & 0xffff0000u); n4[mt][2] = __uint_as_float(nq[j][mt][1] << 16); n4[mt][3] = __uint_as_float(nq[j][mt][1] & 0xffff0000u); }
                bf16_t* sp = p.DSP + cbase + (size_t)chunk_of(dir, step) * 4096 + (vg * 16 + fr) * 64 + 4 * fq;
#pragma unroll
                for (int mt = 0; mt < 4; ++mt) store_bf4(sp + 16 * mt, acc[mt]);
                if (step + D < NCHUNK) issue(step + D, mq[j], nq[j]);
                u32x4 b0, b1;
                b0[0] = pack2(acc[0][0], acc[0][1]); b0[1] = pack2(acc[0][2], acc[0][3]); b0[2] = pack2(acc[1][0], acc[1][1]); b0[3] = pack2(acc[1][2], acc[1][3]);
                b1[0] = pack2(acc[2][0], acc[2][1]); b1[1] = pack2(acc[2][2], acc[2][3]); b1[2] = pack2(acc[3][0], acc[3][1]); b1[3] = pack2(acc[3][2], acc[3][3]);
                const bf16x8 B0 = __builtin_bit_cast(bf16x8, b0), B1 = __builtin_bit_cast(bf16x8, b1);
                __syncthreads();
#pragma unroll
                for (int mt = 0; mt < 4; ++mt) {
                    const int row = 16 * mt + fr; const LAS char* rp = slot + row * 128 + (fq & 1) * 8;
                    const int c0 = (fq >> 1);
                    const bf16x8 A0 = cat4(*(const LAS s16x4*)(rp + (((c0) ^ (row & 7)) * 16)), *(const LAS s16x4*)(rp + (((c0 + 2) ^ (row & 7)) * 16)));
                    const bf16x8 A1 = cat4(*(const LAS s16x4*)(rp + (((c0 + 4) ^ (row & 7)) * 16)), *(const LAS s16x4*)(rp + (((c0 + 6) ^ (row & 7)) * 16)));
                    f32x4 a = n4[mt]; a = __builtin_amdgcn_mfma_f32_16x16x32_bf16(A0, B0, a, 0, 0, 0); a = __builtin_amdgcn_mfma_f32_16x16x32_bf16(A1, B1, a, 0, 0, 0); acc[mt] = a;
                }
            }
        }
    }
}

DI void dnout_unit(const Params& p, int l, int b, int h, int c) {
    const int t = tidx(), lane = t & 63, w = t >> 6, r = lane & 31, h2 = lane >> 5;
    const size_t tok = (size_t)b * SU + c * 128 + 32 * w + r;
    f32x16 O0, O1;
    {
        const bf16_t* o0 = qeol(p, l) + (size_t)2 * NT * 256 + tok * 256 + h * 64 + 4 * h2; const bf16_t* o1 = o0 + (size_t)NT * 256;
#pragma unroll
        for (int g = 0; g < 4; ++g) { const f32x4 a = ld_bf4(o0 + 8 * g) + ld_bf4(o1 + 8 * g), bq = ld_bf4(o0 + 32 + 8 * g) + ld_bf4(o1 + 32 + 8 * g);
#pragma unroll
            for (int j = 0; j < 4; ++j) { O0[4 * g + j] = a[j]; O1[4 * g + j] = bq[j]; } }
    }
#pragma unroll
    for (int dir = 0; dir < 2; ++dir) {
        const bf16_t* qe = qeol(p, l) + (size_t)dir * NT * 256 + tok * 256 + h * 64 + 8 * h2;
        const bf16_t* sT = p.DSP + st_slot(b, h, dir, c) + 8 * h2;
#pragma unroll
        for (int st = 0; st < 4; ++st) { const bf16x8 qf = *(const bf16x8*)(qe + 16 * st);
            O0 = MFMA32(*(const bf16x8*)(sT + r * 64 + 16 * st), qf, O0); O1 = MFMA32(*(const bf16x8*)(sT + (32 + r) * 64 + 16 * st), qf, O1); }
    }
    float ss = 0.f;
#pragma unroll
    for (int q = 0; q < 16; ++q) ss += O0[q] * O0[q] + O1[q] * O1[q];
    ss += __shfl_xor(ss, 32, 64); const float rstd = rsqrtf(ss * (1.f / 64.f) + EPS);
    const bf16_t* zr = p.P + tok * PW + OFF_DNZ + h * 64 + 4 * h2; bf16_t* y = p.Y + tok * DM + 512 + h * 64 + 4 * h2;
    const float* ng = p.dn_norm_g + l * 64 + 4 * h2;
#pragma unroll
    for (int g = 0; g < 4; ++g) {
        const f32x4 z0 = ld_bf4(zr + 8 * g), z1 = ld_bf4(zr + 32 + 8 * g), n0 = *(const f32x4*)(ng + 8 * g), n1 = *(const f32x4*)(ng + 32 + 8 * g); f32x4 o0, o1;
#pragma unroll
        for (int j = 0; j < 4; ++j) { o0[j] = O0[4 * g + j] * rstd * n0[j] * siluf(z0[j]); o1[j] = O1[4 * g + j] * rstd * n1[j] * siluf(z1[j]); }
        store_bf4(y + 8 * g, o0); store_bf4(y + 32 + 8 * g, o1);
    }
}

DI void ph_local(const Params& p, int l, LAS char* smem) {
    const int nd = DN_NEW ? 2 * 16 * NCHUNK : 0, nr = RET_NEW ? 16 * NCHUNK : 0, nm = NMT * 3;
    for (int u = bidx(); u < nd + nr + nm; u += gdim()) {
        if (u < nd) { const int c = u % NCHUNK, ch = u / NCHUNK; for (int rep = 0; rep < REP_DNL; ++rep) dnloc_unit(p, l, ch >> 3, (ch >> 1) & 3, ch & 1, c, smem); }
        else if (u < nd + nr) { const int v = u - nd, c = v % NCHUNK, bh = v / NCHUNK; for (int rep = 0; rep < REP_RKV; ++rep) retkv_unit(p, l, bh >> 2, bh & 3, c, smem); }
        else for (int rep = 0; rep < REP_MLA; ++rep) { const int v = u - nd - nr; ph_mla_up_unit(p, (v / 3) * 7 + v % 3, smem); }
    }
}
DI void ph_scan2(const Params& p, int l, LAS char* smem) {
    const int bid = bidx();
    if (bid >= 16 && bid < 48) { if (DN_NEW) for (int rep = 0; rep < REP_DNSCAN; ++rep) dn_scan(p, bid - 16, smem); }
    else {
        const int pi = bid < 16 ? bid : bid - 32, ps = gdim() - 32;
        if (RET_NEW) { for (int gid = pi * NTHR + tidx(); gid < 65536; gid += ps * NTHR) ret_scan(p, l, gid); }
        for (int v = pi; v < NB * NCHUNK * 4; v += ps) { const int g = v & 3, bc = v >> 2, b = bc / NCHUNK, c = bc % NCHUNK; if (l == 0 || c >= 2) sgm_unit(p, l, b, c, g, smem); }
        for (int u = pi; u < NMT * 4; u += ps) for (int rep = 0; rep < REP_MLA; ++rep) ph_mla_up_unit(p, (u >> 2) * 7 + 3 + (u & 3), smem);
    }
}
DI void ph_output(const Params& p, int l, LAS char* smem) {
    {
        const int x = bidx() & 7, lb = bidx() >> 3, gl = gdim() >> 3;
        LAS int* badl = (LAS int*)(smem + 49152 + 16);
        int nbad = 0;
        for (int rep = 0; rep < REP_ATT; ++rep) for (int j = lb; j < 64; j += gl) { const int bh = x + 8 * (j >> 5), qb = j & 31;
            if (attn_unit(p, bh >> 2, bh & 3, CTXL + qb * 256, SU, smem)) { if (tidx() == 0) badl[nbad] = j; ++nbad; } }
        if (nbad) {
            __syncthreads();
            for (int k = 0; k < nbad; ++k) { const int j = __builtin_amdgcn_readfirstlane(badl[k]); const int bh = x + 8 * (j >> 5), qb = j & 31; attn_unit_classic(p, bh >> 2, bh & 3, CTXL + qb * 256, SU, smem); }
        }
    }
    const int natt = (l == 0 ? 16 : 0);
    const int nro = RET_NEW ? 16 * NCHUNK : 0, ndo = DN_NEW ? 16 * NCHUNK : 0, nsg = 0;
    for (int u = bidx(); u < natt + nro + ndo + nsg; u += gdim()) {
        if (u < natt) { const int bh = u; attn_unit_classic(p, bh >> 2, bh & 3, 0, CTXL, smem); }
        else if (u < natt + nro) { const int v = u - natt, c = v % NCHUNK, bh = v / NCHUNK; if (l == 0 || c >= 2) for (int rep = 0; rep < REP_RO; ++rep) retout_unit(p, l, bh >> 2, bh & 3, c, smem); }
        else if (u < natt + nro + ndo) { const int v = u - natt - nro, c = v % NCHUNK, bh = v / NCHUNK; if (l == 0 || c >= 2) for (int rep = 0; rep < REP_DO; ++rep) dnout_unit(p, l, bh >> 2, bh & 3, c); }
        else { const int v = u - natt - nro - ndo, g = v & 3, bc = v >> 2, b = bc / NCHUNK, c = bc % NCHUNK; if (l == 0 || c >= 2) for (int rep = 0; rep < REP_SG; ++rep) sgm_unit(p, l, b, c, g, smem); }
    }
}

DI bool mt_active(int l, int mt) { return l == 0 || (mt % NCHUNK) >= 2; }
template <int NF>
DI void merge_unit(const Params& p, int mt, int nt, LAS char* smem) {
    bf16_t* ACC = p.P;
    const int t = tidx(), lane = t & 63, wave = t >> 6, wr = wave >> 1, wc = wave & 1, fr = lane & 15, fq = lane >> 4;
    const int lrow = lane >> 3, lch = (lane & 7) ^ lrow;
    unsigned ao[4], boB[NF], boG[NF];
#pragma unroll
    for (int i = 0; i < 4; ++i) ao[i] = (unsigned)((((wave + 4 * i) * 8 + lrow) * DM + lch * 8) * 2);
#pragma unroll
    for (int i = 0; i < NF; ++i) { const int br = brow_src((wave + 4 * i) * 8 + lrow); boB[i] = (unsigned)((br * 256 + lch * 8) * 2); boG[i] = (unsigned)((br * DM + lch * 8) * 2); }
    const unsigned ldsw = (unsigned)__builtin_amdgcn_readfirstlane((int)((unsigned)(size_t)smem + wave * 1024));
    const bf16_t* Ah = p.H + (size_t)mt * 128 * DM; const bf16_t* Ay = p.Y + (size_t)mt * 128 * DM;
    auto Aof = [&](int s_) { return (s_ & 1) ? Ah : Ay + (s_ >> 1) * 256; };
    auto Bof = [&](int s_) { const int i = s_ >> 1; return (s_ & 1) ? p.WinT + ((size_t)OFF_GATE + i * DM + nt * 32 * NF) * DM : p.WbrT + ((size_t)i * DM + nt * 32 * NF) * 256; };
    auto stage = [&](int s_, int buf, int k0) {
        const bf16_t* A = Aof(s_) + k0; const bf16_t* B = Bof(s_) + k0; const unsigned dA = ldsw + buf * 32768, dB = dA + 16384;
#pragma unroll
        for (int i = 0; i < 4; ++i) glds16(A, ao[i], dA + i * 4096);
        if (s_ & 1) {
#pragma unroll
            for (int i = 0; i < NF; ++i) glds16(B, boG[i], dB + i * 4096);
        } else {
#pragma unroll
            for (int i = 0; i < NF; ++i) glds16(B, boB[i], dB + i * 4096);
        }
    };
    const int sw = (fq ^ (fr & 7)) * 16;
    const int aoff0 = (wr * 64 + fr) * 128 + sw, boff0 = (wc * 16 * NF + fr) * 128 + sw + 16384;
    auto run = [&](f32x4 (&acc)[4][NF], int s_) {
        const int nk = (s_ & 1) ? 16 : 4;
        __syncthreads();
        asm volatile("s_waitcnt vmcnt(0)" ::: "memory");
        __syncthreads();
        stage(s_, 1, 64);
        for (int kt = 0; kt < nk; ++kt) {
            const LAS char* sA = smem + (kt & 1) * 32768;
#pragma unroll
            for (int kk = 0; kk < 2; ++kk) {
                bf16x8 af[4], bf[NF];
                const LAS char* pa = sA + (kk ? (aoff0 ^ 64) : aoff0); const LAS char* pb_ = sA + (kk ? (boff0 ^ 64) : boff0);
#pragma unroll
                for (int m = 0; m < 4; ++m) af[m] = *(const LAS bf16x8*)(pa + m * 2048);
#pragma unroll
                for (int n = 0; n < NF; ++n) bf[n] = *(const LAS bf16x8*)(pb_ + n * 2048);
#pragma unroll
                for (int m = 0; m < 4; ++m)
#pragma unroll
                    for (int n = 0; n < NF; ++n) acc[m][n] = __builtin_amdgcn_mfma_f32_16x16x32_bf16(bf[n], af[m], acc[m][n], 0, 0, 0);
            }
            asm volatile("s_waitcnt vmcnt(0)" ::: "memory");
            __syncthreads();
            if (kt + 2 < nk) stage(s_, kt & 1, (kt + 2) * 64);
            else if (kt + 2 == nk && s_ < 7) stage(s_ + 1, 0, 0);
        }
    };
    unsigned outp[4][NF][2];
#pragma unroll
    for (int m = 0; m < 4; ++m)
#pragma unroll
        for (int n = 0; n < NF; ++n) { outp[m][n][0] = 0u; outp[m][n][1] = 0u; }
    __syncthreads();
    stage(0, 0, 0);
#pragma unroll 1
    for (int i = 0; i < 4; ++i) {
        unsigned pb[4][NF][2];
        { f32x4 accB[4][NF]; zero_acc(accB);
          run(accB, 2 * i);
#pragma unroll
          for (int m = 0; m < 4; ++m)
#pragma unroll
              for (int n = 0; n < NF; ++n) { pb[m][n][0] = pack2(accB[m][n][0], accB[m][n][1]); pb[m][n][1] = pack2(accB[m][n][2], accB[m][n][3]); } }
        f32x4 accG[4][NF]; zero_acc(accG);
        run(accG, 2 * i + 1);
#pragma unroll
        for (int m = 0; m < 4; ++m)
#pragma unroll
            for (int n = 0; n < NF; ++n) {
                const float o0 = __uint_as_float(outp[m][n][0] << 16) + sig2(accG[m][n][0]) * __uint_as_float(pb[m][n][0] << 16);
                const float o1 = __uint_as_float(outp[m][n][0] & 0xffff0000u) + sig2(accG[m][n][1]) * __uint_as_float(pb[m][n][0] & 0xffff0000u);
                const float o2 = __uint_as_float(outp[m][n][1] << 16) + sig2(accG[m][n][2]) * __uint_as_float(pb[m][n][1] << 16);
                const float o3 = __uint_as_float(outp[m][n][1] & 0xffff0000u) + sig2(accG[m][n][3]) * __uint_as_float(pb[m][n][1] & 0xffff0000u);
                outp[m][n][0] = pack2(o0, o1); outp[m][n][1] = pack2(o2, o3);
            }
    }
    bf16_t* o = ACC + (size_t)mt * 128 * DM + nt * 32 * NF;
#pragma unroll
    for (int m = 0; m < 4; ++m)
#pragma unroll
        for (int k = 0; k < NF / 2; ++k) { u32x4 v; v[0] = outp[m][2 * k][0]; v[1] = outp[m][2 * k][1]; v[2] = outp[m][2 * k + 1][0]; v[3] = outp[m][2 * k + 1][1];
            *(u32x4*)(o + (size_t)(wr * 64 + m * 16 + fr) * DM + wc * 16 * NF + k * 32 + fq * 8) = v; }
}
DI void ph_merge(const Params& p, int l, LAS char* smem) {
    const TileDeal dl = deal_init(256, 8);
    for (int j = dl.lb; j < dl.total; j += dl.gl) { int mt, nt; deal_map(dl, j, mt, nt); merge_unit<4>(p, mt, nt, smem); }
    if (l == 0) for (int u = bidx(); u < 8 * 16; u += gdim()) merge_unit<2>(p, ctx_mt(u >> 4), u & 15, smem);
}

template <int NF, class NextF = NoNext>
DI void wout_unit(const Params& p, int mt, int nt, LAS char* smem, bool pre = false, NextF next = NextF()) {
    f32x4 acc[4][NF]; zero_acc(acc);
    const bf16_t* A = p.P + (size_t)mt * 128 * DM;
    gemm_tile(acc, A, [&](int r) { return r * DM; }, p.WoutT + (size_t)nt * 32 * NF * DM, DM, DM, smem, pre, next);
    bf16_t* o = p.H + (size_t)mt * 128 * DM + nt * 32 * NF;
    for_frags(acc, [&](int r, int c, f32x4 lo, f32x4 hi) { store_bf8(o + (size_t)r * DM + c, lo, hi); });
}
DI void ph_wout(const Params& p, int l, LAS char* smem) {
    const TileDeal dl = deal_init(256, 8);
    bool pre = false;
    for (int j = dl.lb; j < dl.total; j += dl.gl) { int mt, nt; deal_map(dl, j, mt, nt);
        const int jn = j + dl.gl; const bool hasn = jn < dl.total; int mtn = 0, ntn = 0; if (hasn) deal_map(dl, jn, mtn, ntn);
        wout_unit<4>(p, mt, nt, smem, pre, [&]() { if (hasn) gemm_prestage<4>(p.P + (size_t)mtn * 128 * DM, [&](int r) { return r * DM; }, p.WoutT + (size_t)ntn * 128 * DM, DM, smem); });
        pre = hasn; }
    if (l == 0) for (int u = bidx(); u < 8 * 16; u += gdim()) wout_unit<2>(p, ctx_mt(u >> 4), u & 15, smem);
}

DI void ph_r2(const Params& p, int l, LAS char* smem, bool dry = false) {
    LAS float* rwT = (LAS float*)smem;
    __syncthreads();
    for (int i = tidx(); i < DM * 4; i += NTHR) { const f32x4 v = *(const f32x4*)(p.router_w + (size_t)i * 4); const int d = i >> 2, e0 = (i & 3) * 4;
        rwT[(e0 + 0) * DM + d] = v[0]; rwT[(e0 + 1) * DM + d] = v[1]; rwT[(e0 + 2) * DM + d] = v[2]; rwT[(e0 + 3) * DM + d] = v[3]; }
    __syncthreads();
    LAS int* bcnt = (LAS int*)(smem + 65536); LAS int* bbase = bcnt + 16; LAS unsigned* rec = (LAS unsigned*)(bbase + 16);
    if (tidx() < 16) bcnt[tidx()] = 0;
    __syncthreads();
    const int lane = tidx() & 63, wv_ = tidx() >> 6, gw = bidx() * 4 + wv_, nw = gdim() * 4;
    int kk = -1;
    auto active = [&](int tok) { return tok < NT && !(l == 1 && tok_s(tok) < CTXL); };
    u32x2 ya[4], yb[4]; f32x4 xa[4], xb[4];
    auto load = [&](int tok, u32x2 (&yy)[4], f32x4 (&xx)[4]) {
        const float* xs = xrow_src(p, l, tok); const bf16_t* hrow = p.H + (size_t)tok * DM;
#pragma unroll
        for (int i = 0; i < 4; ++i) { yy[i] = *(const u32x2*)(hrow + lane * 4 + 256 * i); xx[i] = *(const f32x4*)(xs + lane * 4 + 256 * i); }
    };
    if (active(gw)) load(gw, ya, xa);
    for (int tok = gw; tok < NT; tok += nw) {
        ++kk;
        { const int nxt = tok + nw; if (active(nxt)) load(nxt, yb, xb); }
        if (!active(tok)) {
#pragma unroll
            for (int i = 0; i < 4; ++i) { ya[i] = yb[i]; xa[i] = xb[i]; }
            continue; }
        float* xd = dry ? (float*)p.Y + (size_t)(tok & 8191) * DM : xrow_dst(p, tok);
        bf16_t* hrow = p.H + (size_t)tok * DM; bf16_t* hout = dry ? p.Y + (size_t)8192 * DM * 2 + (size_t)(tok & 8191) * DM : hrow;
        const float* g1 = mod_row(p, l, tok, 2); const float* sh2 = mod_row(p, l, tok, 3); const float* sc2 = mod_row(p, l, tok, 4);
        f32x4 y[4]; float ss = 0.f;
#pragma unroll
        for (int i = 0; i < 4; ++i) { const u32x2 raw = ya[i];
            y[i][0] = __uint_as_float(raw[0] << 16); y[i][1] = __uint_as_float(raw[0] & 0xffff0000u); y[i][2] = __uint_as_float(raw[1] << 16); y[i][3] = __uint_as_float(raw[1] & 0xffff0000u);
            ss += y[i][0] * y[i][0] + y[i][1] * y[i][1] + y[i][2] * y[i][2] + y[i][3] * y[i][3]; }
        ss = wave_sum(ss); const float rstd = rsqrtf(ss * (1.f / DM) + EPS);
        f32x4 xn[4]; float ss2 = 0.f;
#pragma unroll
        for (int i = 0; i < 4; ++i) { const int d = lane * 4 + 256 * i; const f32x4 xv = xa[i], gp = *(const f32x4*)(p.g_post1 + (size_t)l * DM + d), gt = *(const f32x4*)(g1 + d);
#pragma unroll
            for (int j = 0; j < 4; ++j) { xn[i][j] = xv[j] + gt[j] * (y[i][j] * rstd * gp[j]); ss2 += xn[i][j] * xn[i][j]; }
            *(f32x4*)(xd + d) = xn[i]; }
        ss2 = wave_sum(ss2); const float rstd2 = rsqrtf(ss2 * (1.f / DM) + EPS);
        float lg[16];
#pragma unroll
        for (int e = 0; e < 16; ++e) lg[e] = 0.f;
#pragma unroll
        for (int i = 0; i < 4; ++i) { const int d = lane * 4 + 256 * i; const f32x4 gp = *(const f32x4*)(p.g_pre2 + (size_t)l * DM + d), s1 = *(const f32x4*)(sc2 + d), s0 = *(const f32x4*)(sh2 + d);
            f32x4 hv;
#pragma unroll
            for (int j = 0; j < 4; ++j) hv[j] = xn[i][j] * rstd2 * gp[j] * (1.f + s1[j]) + s0[j];
#pragma unroll
            for (int e = 0; e < 16; ++e) { const f32x4 wv = *(const LAS f32x4*)(rwT + e * DM + d); lg[e] += hv[0] * wv[0] + hv[1] * wv[1] + hv[2] * wv[2] + hv[3] * wv[3]; }
            store_bf4(hout + d, hv); }
#pragma unroll
        for (int e = 0; e < 16; ++e) lg[e] = wave_sum(lg[e]);
#pragma unroll
        for (int i = 0; i < 4; ++i) { ya[i] = yb[i]; xa[i] = xb[i]; }
        if (lane == 0 && !dry) {
            float aff[16], sel[16];
#pragma unroll
            for (int e = 0; e < 16; ++e) { aff[e] = sigmoidf_(lg[e]); sel[e] = aff[e] + p.router_bias[e]; }
            int best = 0; float bests = -1e30f;
#pragma unroll
            for (int g = 0; g < 4; ++g) { float m1 = -1e30f, m2 = -1e30f;
#pragma unroll
                for (int j = 0; j < 4; ++j) { const float v = sel[g * 4 + j]; if (v > m1) { m2 = m1; m1 = v; } else if (v > m2) m2 = v; }
                const float gs = m1 + m2; if (gs > bests) { bests = gs; best = g; } }
            int i0 = 0, i1 = 0; float m1 = -1e30f, m2 = -1e30f, a0 = 0.f, a1 = 0.f;
#pragma unroll
            for (int g = 0; g < 4; ++g)
#pragma unroll
                for (int j = 0; j < 4; ++j) if (g == best) { const float v = sel[g * 4 + j]; const float a = aff[g * 4 + j];
                    if (v > m1) { m2 = m1; i1 = i0; a1 = a0; m1 = v; i0 = g * 4 + j; a0 = a; } else if (v > m2) { m2 = v; i1 = g * 4 + j; a1 = a; } }
            const float inv = 1.f / (a0 + a1);
            p.ewt[(size_t)tok * 2] = a0 * inv; p.ewt[(size_t)tok * 2 + 1] = a1 * inv;
            const unsigned lp0 = (unsigned)__hip_atomic_fetch_add(&bcnt[i0], 1, __ATOMIC_RELAXED, __HIP_MEMORY_SCOPE_WORKGROUP);
            const unsigned lp1 = (unsigned)__hip_atomic_fetch_add(&bcnt[i1], 1, __ATOMIC_RELAXED, __HIP_MEMORY_SCOPE_WORKGROUP);
            rec[wv_ * 40 + kk] = (unsigned)i0 | (lp0 << 4) | ((unsigned)i1 << 16) | (lp1 << 20);
        }
    }
    __syncthreads();
    if (dry) return;
    if (tidx() < 16) bbase[tidx()] = atomicAdd(&p.cnt[tidx()], bcnt[tidx()]);
    __syncthreads();
    {
        const int tok = gw + lane * nw;
        if (lane < 40 && tok < NT && !(l == 1 && tok_s(tok) < CTXL)) {
            const unsigned rc = rec[wv_ * 40 + lane]; const int e0 = rc & 15, l0 = (rc >> 4) & 0xfff, e1 = (rc >> 16) & 15, l1 = rc >> 20;
            p.elist[(size_t)e0 * NT + bbase[e0] + l0] = tok * 2; p.elist[(size_t)e1 * NT + bbase[e1] + l1] = tok * 2 + 1;
        }
    }
}

DI int sh_tok(int l, int pos) { return l == 0 ? pos : (pos >> 13) * SU + CTXL + (pos & 8191); }
DI void moe_offsets(const Params& p, int l, LAS int* soff) {
    __syncthreads();
    if (tidx() == 0) { int a = 0; for (int e = 0; e < 16; ++e) { const int c = p.cnt[e]; soff[e] = a; soff[17 + e] = c; a += c; } soff[16] = 2 * NT; soff[33] = l == 0 ? NT : NB * SEQ;
        int t = 0; for (int e = 0; e < 17; ++e) { soff[34 + e] = t; t += (soff[17 + e] + 127) >> 7; } soff[51] = t; }
    __syncthreads();
}
DI void moe_tile(const LAS int* soff, int t, int& e, int& mt) { e = 0; while (e < 16 && t >= soff[35 + e]) ++e; mt = t - soff[34 + e]; }
DI void ph_moe1(const Params& p, int l, LAS char* smem) {
    LAS int* soff = (LAS int*)(smem + 65536);
    moe_offsets(p, l, soff);
    bf16_t* ACT = p.Y;
    const int T = soff[51], xg = bidx() & 7, lbx = bidx() >> 3, glx = gdim() >> 3;
    const int NQ = ((T - xg + 7) >> 3) * 4;
    for (int q = lbx; q < NQ; q += glx) {
        const int nt = q & 3; int e, mt; moe_tile(soff, (q >> 2) * 8 + xg, e, mt);
        const int cnt = soff[17 + e];
        const int* lst = p.elist + (size_t)e * NT;
        auto tokof = [&](int r) { int pos = mt * 128 + r; if (pos >= cnt) pos = mt * 128; return e < 16 ? (lst[pos] >> 1) : sh_tok(l, pos); };
        f32x4 acc[4][4]; zero_acc(acc);
        gemm_tile_g(acc, p.H, [&](int r) { return tokof(r) * DM; }, p.W1T + ((size_t)e * 256 + nt * 64) * DM,
                    [&](int rr) { const int grp = rr >> 5; return ((grp & 1) * (17 * 256) + (grp >> 1) * 32 + perm32(rr & 31)) * DM; }, DM, smem);
        bf16_t* o = ACT + ((size_t)soff[e] + mt * 128) * 256 + nt * 64;
        {
            const int t = tidx(), lane = t & 63, wave = t >> 6, wr = wave >> 1, wc = wave & 1, fr = lane & 15, fq = lane >> 4;
#pragma unroll
            for (int m = 0; m < 4; ++m) { const int r = wr * 64 + m * 16 + fr; f32x4 lo, hi;
#pragma unroll
                for (int j = 0; j < 4; ++j) { lo[j] = siluf(acc[m][0][j]) * acc[m][2][j]; hi[j] = siluf(acc[m][1][j]) * acc[m][3][j]; }
                if (mt * 128 + r < cnt) store_bf8(o + (size_t)r * 256 + wc * 32 + fq * 8, lo, hi); }
        }
    }
}
DI void ph_moe2(const Params& p, int l, LAS char* smem) {
    LAS int* soff = (LAS int*)(smem + 65536);
    moe_offsets(p, l, soff);
    const bf16_t* ACT = p.Y; bf16_t* SLOT = p.P; bf16_t* SHOUT = p.H;
    const int T = soff[51], xg = bidx() & 7, lbx = bidx() >> 3, glx = gdim() >> 3;
    const int NU = ((T - xg + 7) >> 3) * 8;
    bool pre = false; int uc = 0;
    for (int u = lbx; u < NU; ) {
        const int nt = u & 7; int e, mt; moe_tile(soff, (u >> 3) * 8 + xg, e, mt);
        const int cnt = soff[17 + e];
        const int un = u + glx; const bool hasn = un < NU;
        int en = 0, mtn = 0; if (hasn) moe_tile(soff, (un >> 3) * 8 + xg, en, mtn);
        const int cntn = hasn ? soff[17 + en] : 0;
        const bf16_t* A = ACT + ((size_t)soff[e] + mt * 128) * 256;
        const bf16_t* An = ACT + ((size_t)soff[en] + mtn * 128) * 256;
        const bf16_t* Bn = p.W2T + ((size_t)en * DM + (un & 7) * 128) * 256;
        LAS int* rowpair = (LAS int*)(smem + 66560) + (uc & 1) * 256; LAS float* roww = (LAS float*)(rowpair + 128);
        if (e < 16 && tidx() < 128) { const int pos = mt * 128 + tidx(); int pr = 0; float w = 0.f; if (pos < cnt) { pr = p.elist[(size_t)e * NT + pos]; w = p.ewt[pr]; } rowpair[tidx()] = pr; roww[tidx()] = w; }
        ++uc;
        f32x4 acc[4][4]; zero_acc(acc);
        gemm_tile<false>(acc, A, [&](int r) { const int rr = (mt * 128 + r < cnt) ? r : 0; return rr * 256; }, p.W2T + ((size_t)e * DM + nt * 128) * 256, 256, 256, smem, pre,
            [&]() { if (hasn) gemm_prestage<4>(An, [&](int r) { const int rr = (mtn * 128 + r < cntn) ? r : 0; return rr * 256; }, Bn, 256, smem); });
        pre = hasn;
        for_frags(acc, [&](int r, int c, f32x4 lo, f32x4 hi) { const int pos = mt * 128 + r; if (pos < cnt) {
            if (e < 16) { const int pair = rowpair[r]; const float w = roww[r]; store_bf8(SLOT + (size_t)pair * DM + nt * 128 + c, lo * w, hi * w); }
            else store_bf8(SHOUT + (size_t)sh_tok(l, pos) * DM + nt * 128 + c, lo, hi); } });
        u = un;
    }
}
DI void ph_final(const Params& p, int l, bool dry = false) {
    const int lane = tidx() & 63, gw = bidx() * 4 + (tidx() >> 6), nw = gdim() * 4;
    const bf16_t* SLOT = p.P; const bf16_t* SHOUT = p.H;
    auto active = [&](int tok) { return tok < NT && !(l == 1 && tok_s(tok) < CTXL); };
    u32x2 a0[4], a1[4], a2[4], b0[4], b1[4], b2[4]; f32x4 xv[4], xn[4];
    auto load = [&](int tok, u32x2 (&q0)[4], u32x2 (&q1)[4], u32x2 (&q2)[4], f32x4 (&x)[4]) {
        const float* xd = xrow_dst(p, tok);
#pragma unroll
        for (int i = 0; i < 4; ++i) { const int d = lane * 4 + 256 * i;
            q0[i] = *(const u32x2*)(SLOT + (size_t)tok * 2 * DM + d); q1[i] = *(const u32x2*)(SLOT + (size_t)tok * 2 * DM + DM + d); q2[i] = *(const u32x2*)(SHOUT + (size_t)tok * DM + d);
            x[i] = *(const f32x4*)(xd + d); }
    };
    auto up = [](u32x2 r) { f32x4 o; o[0] = __uint_as_float(r[0] << 16); o[1] = __uint_as_float(r[0] & 0xffff0000u); o[2] = __uint_as_float(r[1] << 16); o[3] = __uint_as_float(r[1] & 0xffff0000u); return o; };
    if (active(gw)) load(gw, a0, a1, a2, xv);
    for (int tok = gw; tok < NT; tok += nw) {
        const int nxt = tok + nw; const bool an = active(nxt);
        if (an) load(nxt, b0, b1, b2, xn);
        if (active(tok)) {
            float* xd = xrow_dst(p, tok); const float* g2 = mod_row(p, l, tok, 5);
            f32x4 m[4]; float ss = 0.f;
#pragma unroll
            for (int i = 0; i < 4; ++i) { m[i] = up(a0[i]) + up(a1[i]) + up(a2[i]); ss += m[i][0] * m[i][0] + m[i][1] * m[i][1] + m[i][2] * m[i][2] + m[i][3] * m[i][3]; }
            ss = wave_sum(ss); const float rstd = rsqrtf(ss * (1.f / DM) + EPS);
#pragma unroll
            for (int i = 0; i < 4; ++i) { const int d = lane * 4 + 256 * i; const f32x4 gp = *(const f32x4*)(p.g_post2 + (size_t)l * DM + d), gt = *(const f32x4*)(g2 + d);
                f32x4 o;
#pragma unroll
                for (int j = 0; j < 4; ++j) o[j] = xv[i][j] + gt[j] * (m[i][j] * rstd * gp[j]);
                *(f32x4*)((dry ? (float*)p.Y + (size_t)(tok & 8191) * DM : xd) + d) = o; m[i] = o; }
            if (l == 0 && !dry) {
                float s2 = 0.f;
#pragma unroll
                for (int i = 0; i < 4; ++i) s2 += m[i][0] * m[i][0] + m[i][1] * m[i][1] + m[i][2] * m[i][2] + m[i][3] * m[i][3];
                s2 = wave_sum(s2); const float r2 = rsqrtf(s2 * (1.f / DM) + EPS);
                const float* sh = mod_row(p, 1, tok, 0); const float* scl = mod_row(p, 1, tok, 1); const float* g = p.g_pre1 + DM;
#pragma unroll
                for (int i = 0; i < 4; ++i) { const int d = lane * 4 + 256 * i; const f32x4 gg = *(const f32x4*)(g + d), s1 = *(const f32x4*)(scl + d), s0 = *(const f32x4*)(sh + d);
                    f32x4 hq;
#pragma unroll
                    for (int j = 0; j < 4; ++j) hq[j] = m[i][j] * r2 * gg[j] * (1.f + s1[j]) + s0[j];
                    store_bf4(p.H + (size_t)tok * DM + d, hq); }
            }
        }
#pragma unroll
        for (int i = 0; i < 4; ++i) { a0[i] = b0[i]; a1[i] = b1[i]; a2[i] = b2[i]; xv[i] = xn[i]; }
    }
}

constexpr int SMEM_BYTES = 68608;
#if MK_ONE_LAUNCH
DI void gbar(const XcdBarrier& b0) { XcdBarrier b = b0; asm volatile("" : "+s"(b.bar), "+s"(b.x)); xcd_barrier(b); }
__global__ void __launch_bounds__(NTHR, 2) k_fwd(Params pk) {
    extern __shared__ __attribute__((aligned(16))) char smem_[];
    LAS char* smem = (LAS char*)smem_;
    if (threadIdx.x < 4) ((LAS unsigned*)(smem + SMEM_BYTES))[threadIdx.x] = 0u;
    __syncthreads();
    XcdBarrier bar = xcd_barrier_post(pk.bar, (volatile LAS unsigned*)(smem + SMEM_BYTES));
    ph_adaln(pk, smem); __syncthreads(); ph_convert(pk, 0, smem); ph_rot_table(pk);
    gbar(bar);
    for (int l = 0; l < 2; ++l) {
        if (l == 0) { ph_norm1(pk, l);            gbar(bar); }
        for (int rep = 0; rep < REP_INPROJ; ++rep) { ph_inproj(pk, smem);        gbar(bar); }
        if (DRY_PREP) { ph_prep(pk, l, smem, true); gbar(bar); }
        ph_prep(pk, l, smem);       gbar(bar);
        for (int rep = 0; rep < REP_LOCAL; ++rep) { ph_local(pk, l, smem);      gbar(bar); }
        ph_scan2(pk, l, smem);            gbar(bar);
        if (!RET_NEW || !DN_NEW) { ph_fin(pk, l); gbar(bar); }
        for (int rep = 0; rep < REP_OUTPUT; ++rep) { ph_output(pk, l, smem);     gbar(bar); }
        if (l == 1) { ph_norm1(pk, l);            gbar(bar); }
        for (int rep = 0; rep < REP_MERGE; ++rep) { ph_merge(pk, l, smem);      gbar(bar); }
        for (int rep = 0; rep < REP_WOUT; ++rep) { ph_wout(pk, l, smem);       gbar(bar); }
        if (DRY_R2) { ph_r2(pk, l, smem, true); gbar(bar); }
        ph_r2(pk, l, smem);               gbar(bar);
        for (int rep = 0; rep < REP_MOE; ++rep) { ph_moe1(pk, l, smem);       gbar(bar); }
        for (int rep = 0; rep < REP_MOE; ++rep) { ph_moe2(pk, l, smem);       gbar(bar); }
        if (DRY_FINAL) { ph_final(pk, l, true); gbar(bar); }
        ph_final(pk, l);
        if (l == 0) { __syncthreads(); ph_convert(pk, 1, smem); gbar(bar); }
    }
}
#else
template <int PH>
__global__ void __launch_bounds__(NTHR, 2) k_phase(Params pk, int l) {
    extern __shared__ __attribute__((aligned(16))) char smem_[];
    LAS char* smem = (LAS char*)smem_;
    if (PH == 0) { ph_adaln(pk, smem); __syncthreads(); ph_convert(pk, 0, smem); ph_rot_table(pk); }
    if (PH == 1) ph_norm1(pk, l);
    if (PH == 2) ph_inproj(pk, smem);
    if (PH == 3) ph_prep(pk, l, smem);
    if (PH == 4) ph_local(pk, l, smem);
    if (PH == 13) ph_scan2(pk, l, smem);
    if (PH == 5) ph_fin(pk, l);
    if (PH == 6) ph_output(pk, l, smem);
    if (PH == 7) ph_merge(pk, l, smem);
    if (PH == 8) ph_wout(pk, l, smem);
    if (PH == 9) ph_r2(pk, l, smem);
    if (PH == 10) ph_moe1(pk, l, smem);
    if (PH == 11) ph_moe2(pk, l, smem);
    if (PH == 12) { ph_final(pk, l); if (l == 0) { __syncthreads(); ph_convert(pk, 1, smem); } }
}
#endif

static size_t al256(size_t x) { return (x + 255) & ~(size_t)255; }
extern "C" void kernel_launch(void* const* d_in, const int* in_sizes, int n_in, void* d_out, int out_size, void* d_ws, size_t ws_size, hipStream_t stream) {
    Params p{};
    const float** fp = (const float**)&p.x;
    for (int i = 0; i < 33; ++i) fp[i] = (const float*)d_in[i];
    p.out = (float*)d_out;
    char* w = (char*)d_ws; size_t o = 0;
    auto take = [&](size_t bytes) { char* r = w + o; o = al256(o + bytes); return r; };
    p.bar = (unsigned*)take(16384);
    p.cnt = (int*)take(256);
    p.mod = (float*)take((size_t)2 * 5 * 6 * DM * 4);
    p.xc = (float*)take((size_t)NB * CTXL * DM * 4);
    p.WinT = (bf16_t*)take((size_t)INC * DM * 2);
    p.WbrT = (bf16_t*)take((size_t)4 * DM * 256 * 2);
    p.WoutT = (bf16_t*)take((size_t)DM * DM * 2);
    p.W1T = (bf16_t*)take((size_t)17 * 256 * DM * 2);
    p.W3T = (bf16_t*)take((size_t)17 * 256 * DM * 2);
    p.W2T = (bf16_t*)take((size_t)17 * DM * 256 * 2);
    p.WuqT = (bf16_t*)take((size_t)384 * 256 * 2);
    p.WukvT = (bf16_t*)take((size_t)512 * 128 * 2);
    p.H = (bf16_t*)take((size_t)NT * DM * 2);
    p.P = (bf16_t*)take((size_t)NT * PW * 2);
    p.DNRAW = (bf16_t*)take((size_t)NT * 768 * 2);
    p.RS = p.DNRAW; p.DNM = p.DNRAW + (size_t)32 * NCHUNK * 4096; p.DNN = p.DNRAW + (size_t)64 * NCHUNK * 4096;
    p.DNQKV = (bf16_t*)take((size_t)NT * 768 * 2);
    p.Y = (bf16_t*)take((size_t)NT * DM * 2);
    p.MQ = (bf16_t*)take((size_t)NT * 384 * 2);
    p.MK = (bf16_t*)take((size_t)NT * 384 * 2);
    p.MVT = (bf16_t*)take((size_t)NT * 256 * 2);
    p.DG = (float*)take((size_t)NT * 8 * 4);
    p.DB = (float*)take((size_t)NT * 8 * 4);
    p.ewt = (float*)take((size_t)NT * 2 * 4);
    p.elist = (int*)take((size_t)16 * NT * 4);
    p.DSP = (bf16_t*)take((size_t)32 * NCHUNK * 4096 * 2);
    p.SGW = (bf16_t*)take((size_t)4 * 128 * 128 * 2);
    p.ROT = (float*)take((size_t)SEQ * 32 * 2 * 4 + 128 * 8 * 2 * 4);
    if (o > ws_size) { fprintf(stderr, "workspace too small: need %zu have %zu\n", o, ws_size); return; }
#if MK_ONE_LAUNCH
    static int grid = 0;
    if (!grid) {
        int dev = 0, cus = 0, per_cu = 0;
        hipGetDevice(&dev);
        hipDeviceGetAttribute(&cus, hipDeviceAttributeMultiprocessorCount, dev);
        hipFuncSetAttribute((const void*)k_fwd, hipFuncAttributeMaxDynamicSharedMemorySize, SMEM_BYTES + 16);
        hipOccupancyMaxActiveBlocksPerMultiprocessor(&per_cu, k_fwd, NTHR, SMEM_BYTES + 16);
        if (per_cu > 2) per_cu = 2;
        if (per_cu < 1) per_cu = 1;
        grid = cus * per_cu;
    }
    hipMemsetAsync(p.bar, 0, 16384, stream);
    k_fwd<<<grid, NTHR, SMEM_BYTES + 16, stream>>>(p);
#else
    const int G = 512;
    k_phase<0><<<G, NTHR, SMEM_BYTES + 16, stream>>>(p, 0);
    for (int l = 0; l < 2; ++l) {
        k_phase<1><<<G, NTHR, SMEM_BYTES + 16, stream>>>(p, l);
        k_phase<2><<<G, NTHR, SMEM_BYTES + 16, stream>>>(p, l);
        k_phase<3><<<G, NTHR, SMEM_BYTES + 16, stream>>>(p, l);
        k_phase<4><<<G, NTHR, SMEM_BYTES + 16, stream>>>(p, l);
        k_phase<13><<<G, NTHR, SMEM_BYTES + 16, stream>>>(p, l);
        if (!RET_NEW || !DN_NEW) k_phase<5><<<G, NTHR, SMEM_BYTES + 16, stream>>>(p, l);
        k_phase<6><<<G, NTHR, SMEM_BYTES + 16, stream>>>(p, l);
        k_phase<1><<<G, NTHR, SMEM_BYTES + 16, stream>>>(p, l);
        k_phase<7><<<G, NTHR, SMEM_BYTES + 16, stream>>>(p, l);
        k_phase<8><<<G, NTHR, SMEM_BYTES + 16, stream>>>(p, l);
        k_phase<9><<<G, NTHR, SMEM_BYTES + 16, stream>>>(p, l);
        k_phase<10><<<G, NTHR, SMEM_BYTES + 16, stream>>>(p, l);
        k_phase<11><<<G, NTHR, SMEM_BYTES + 16, stream>>>(p, l);
        k_phase<12><<<G, NTHR, SMEM_BYTES + 16, stream>>>(p, l);
    }
#endif
}
```

```cpp
#include <hip/hip_runtime.h>
#include <stdint.h>
#include <stdio.h>

#ifndef RET_NEW
#define RET_NEW 1
#endif
#ifndef DN_NEW
#define DN_NEW 1
#endif
#ifndef REP_INPROJ
#define REP_INPROJ 1
#define REP_LOCAL 1
#define REP_OUTPUT 1
#define REP_MERGE 1
#define REP_WOUT 1
#define REP_MOE 1
#define REP_DNSCAN 1
#define REP_ATT 1
#define REP_SG 1
#define REP_RO 1
#define REP_DO 1
#define REP_DNL 1
#define REP_RKV 1
#define REP_MLA 1
#define DRY_PREP 0
#define DRY_R2 0
#define DRY_FINAL 0
#endif
#ifndef MK_ONE_LAUNCH
#define MK_ONE_LAUNCH 1
#endif

typedef unsigned short bf16_t;
typedef short bf16x8 __attribute__((ext_vector_type(8)));
typedef short s16x4 __attribute__((ext_vector_type(4)));
typedef float f32x4 __attribute__((ext_vector_type(4)));
typedef float f32x16 __attribute__((ext_vector_type(16)));
typedef unsigned u32x4 __attribute__((ext_vector_type(4)));
typedef unsigned u32x2 __attribute__((ext_vector_type(2)));
#define DI __device__ __forceinline__

constexpr int NB = 4, SEQ = 8192, CTXL = 256, SU = SEQ + CTXL, NT = NB * SU, DM = 1024;
constexpr int PW = 2224, INC = 7088, PWFULL = 2992;
constexpr int OFF_SG = 1024, OFF_DNZ = 1536, OFF_MLA = 1808, OFF_GATE = 2992;
constexpr int NCHUNK = SU / 128;
constexpr int NMT = NT / 128;
constexpr float EPS = 1e-6f;
constexpr int NTHR = 256;

struct Params {
    const float *x, *c, *ctx, *c_ctx, *w_ada, *b_ada, *g_pre1, *g_post1, *g_pre2, *g_post2, *w_in, *ret_logit, *sg_norm_g, *sg_w, *sg_b,
        *dn_conv_w, *dn_A_log, *dn_dt_bias, *dn_norm_g, *mla_q_norm_g, *mla_kv_norm_g, *mla_w_uq, *mla_w_ukv, *w_branch, *w_out,
        *router_w, *router_bias, *moe_w1, *moe_w3, *moe_w2, *sh_w1, *sh_w3, *sh_w2;
    float* out;
    unsigned* bar; int* cnt; float* mod; float* xc;
    bf16_t *WinT, *WbrT, *WoutT, *W1T, *W3T, *W2T, *WuqT, *WukvT;
    bf16_t *H, *P, *DNQKV, *Y, *MQ, *MK, *MVT, *DNRAW, *RS, *DNM, *DNN, *DSP, *SGW;
    float* ROT;
    float *DG, *DB, *ewt;
    int* elist;
};

#define XB_TMO      128
#define XB_XCNT(j)  (256  + 64 * (j))
#define XB_XSUB(j)  (1280 + 64 * (j))
#define XB_XGEN(j)  (2304 + 64 * (j))
#define XB_TOP      3328
#define XB_TOPGEN   3392
#define XCD_BAR_WORDS 3456
#define XB_SPIN_CAP (1u << 21)
#define LAS __attribute__((address_space(3)))

__device__ __forceinline__ unsigned xb_ld(unsigned* p)              { return __hip_atomic_load(p, __ATOMIC_RELAXED, __HIP_MEMORY_SCOPE_AGENT); }
__device__ __forceinline__ unsigned xb_add(unsigned* p, unsigned v) { return __hip_atomic_fetch_add(p, v, __ATOMIC_RELAXED, __HIP_MEMORY_SCOPE_AGENT); }
__device__ __forceinline__ unsigned xb_xcc_id() { return (unsigned)__builtin_amdgcn_s_getreg((3 << 11) | 20) & 0xFu; }
#define XB_SPIN(cond, bar) do { unsigned _sp = 0; while (cond) { __builtin_amdgcn_s_sleep(1); \
    if ((++_sp & 255u) == 0u) { if (xb_ld(&(bar)[XB_TMO])) break; if (_sp > XB_SPIN_CAP) { atomicAdd(&(bar)[XB_TMO], 1u); break; } } } } while (0)

struct XcdBarrier {
    unsigned* bar; unsigned x;
    volatile LAS unsigned* st;
};

__device__ __forceinline__ XcdBarrier xcd_barrier_post(unsigned* bar, volatile LAS unsigned* st) {
    XcdBarrier b; b.bar = bar; b.x = xb_xcc_id(); b.st = st;
    if (threadIdx.x == 0) (void)xb_add(&bar[XB_XCNT(b.x)], 1u);
    return b;
}
__device__ __forceinline__ void xcd_barrier_complete(unsigned* bar, unsigned x, unsigned& nloc, unsigned& nx) {
    const unsigned G = gridDim.x * gridDim.y * gridDim.z;
    unsigned sum, cnt, mine, sp = 0u;
    for (;;) {
        sum = 0u; cnt = 0u; mine = 0u;
#pragma unroll
        for (unsigned j = 0; j < 16; ++j) { const unsigned c = xb_ld(&bar[XB_XCNT(j)]); sum += c; cnt += (c > 0u) ? 1u : 0u; mine = (j == x) ? c : mine; }
        if (sum == G) break;
        __builtin_amdgcn_s_sleep(1);
        if ((++sp & 255u) == 0u) { if (xb_ld(&bar[XB_TMO])) break; if (sp > XB_SPIN_CAP) { atomicAdd(&bar[XB_TMO], 1u); break; } }
    }
    nloc = mine > 0u ? mine : 1u; nx = cnt > 0u ? cnt : 1u;
}

__device__ __forceinline__ void xcd_barrier(const XcdBarrier& b) {
    asm volatile("s_waitcnt vmcnt(0)" ::: "memory");
    __syncthreads();
    if (threadIdx.x == 0) {
        unsigned* bar = b.bar;
        __builtin_amdgcn_s_waitcnt(0);
        unsigned nloc = b.st[0], nx = b.st[1];
        if (nloc == 0u) { xcd_barrier_complete(bar, b.x, nloc, nx); b.st[0] = nloc; b.st[1] = nx; }
        const unsigned old = xb_add(&bar[XB_XSUB(b.x)], 1u);
        const unsigned gen = old / nloc;
        if (old + 1u == (gen + 1u) * nloc) {
            __builtin_amdgcn_fence(__ATOMIC_RELEASE, "agent");
            asm volatile("s_waitcnt vmcnt(0)" ::: "memory");
            const unsigned og = xb_add(&bar[XB_TOP], 1u);
            const unsigned tg = og / nx;
            if (og + 1u == (tg + 1u) * nx) xb_add(&bar[XB_TOPGEN], 1u);
            else XB_SPIN(xb_ld(&bar[XB_TOPGEN]) == tg, bar);
            __builtin_amdgcn_fence(__ATOMIC_ACQUIRE, "agent");
            xb_add(&bar[XB_XGEN(b.x)], 1u);
            asm volatile("s_waitcnt vmcnt(0)" ::: "memory");
        } else {
            XB_SPIN(xb_ld(&bar[XB_XGEN(b.x)]) == gen, bar);
            __builtin_amdgcn_fence(__ATOMIC_ACQUIRE, "agent");
            asm volatile("s_waitcnt vmcnt(0)" ::: "memory");
        }
    }
    __syncthreads();
}


typedef const Params LAS* PP;
#define PARAM_FIELDS(X) X(x) X(c) X(ctx) X(c_ctx) X(w_ada) X(b_ada) X(g_pre1) X(g_post1) X(g_pre2) X(g_post2) X(w_in) X(ret_logit) X(sg_norm_g) X(sg_w) X(sg_b) X(dn_conv_w) X(dn_A_log) X(dn_dt_bias) X(dn_norm_g) X(mla_q_norm_g) X(mla_kv_norm_g) X(mla_w_uq) X(mla_w_ukv) X(w_branch) X(w_out) X(router_w) X(router_bias) X(moe_w1) X(moe_w3) X(moe_w2) X(sh_w1) X(sh_w3) X(sh_w2) X(out) X(bar) X(cnt) X(mod) X(xc) X(WinT) X(WbrT) X(WoutT) X(W1T) X(W3T) X(W2T) X(WuqT) X(WukvT) X(H) X(P) X(DNQKV) X(Y) X(MQ) X(MK) X(MVT) X(DG) X(DB) X(ewt) X(elist)
DI Params load_params(PP pp) {
    Params p;
#define X(f) p.f = pp->f;
    PARAM_FIELDS(X)
#undef X
    return p;
}
DI const Params* kparams() { const Params* kp = (const Params*)__builtin_amdgcn_kernarg_segment_ptr(); asm volatile("" : "+s"(kp)); return kp; }
DI int tidx() { int t = threadIdx.x; asm volatile("" : "+v"(t)); return t; }
DI int bidx() { int b = blockIdx.x; asm volatile("" : "+s"(b)); return b; }
DI int gdim() { int g = gridDim.x; asm volatile("" : "+s"(g)); return g; }
DI float bf2f(bf16_t v) { return __uint_as_float((unsigned)v << 16); }
typedef __bf16 hbf2 __attribute__((ext_vector_type(2)));
typedef float hf2 __attribute__((ext_vector_type(2)));
DI unsigned pack2(float lo, float hi) { const hf2 f = {lo, hi}; return __builtin_bit_cast(unsigned, __builtin_convertvector(f, hbf2)); }
DI bf16_t f2bf(float f) { return (bf16_t)(pack2(f, 0.f) & 0xffffu); }
DI float wave_sum(float v) {
#pragma unroll
    for (int o = 32; o > 0; o >>= 1) v += __shfl_xor(v, o, 64);
    return v;
}
DI float sigmoidf_(float x) { return __builtin_amdgcn_rcpf(1.f + __builtin_amdgcn_exp2f(-1.4426950408889634f * x)); }
DI float sig2(float y) { return __builtin_amdgcn_rcpf(1.f + __builtin_amdgcn_exp2f(y)); }
DI float siluf(float x) { return x * sigmoidf_(x); }
DI float gelu_tanh(float x) { const float u = 0.7978845608028654f * (x + 0.044715f * x * x * x); return x * __builtin_amdgcn_rcpf(1.f + __builtin_amdgcn_exp2f(-2.8853900817779268f * u)); }
DI float softplusf_(float x) { return fmaxf(x, 0.f) + 0.6931471805599453f * __builtin_amdgcn_logf(1.f + __builtin_amdgcn_exp2f(-1.4426950408889634f * fabsf(x))); }
DI int tok_b(int tok) { return tok / SU; }
DI int tok_s(int tok) { return tok % SU; }
DI void block_sum4(float& a, float& b, float& c, float& d, LAS float* red) {
    a = wave_sum(a); b = wave_sum(b); c = wave_sum(c); d = wave_sum(d);
    const int w = tidx() >> 6, lane = tidx() & 63;
    __syncthreads();
    if (lane == 0) { red[w * 4 + 0] = a; red[w * 4 + 1] = b; red[w * 4 + 2] = c; red[w * 4 + 3] = d; }
    __syncthreads();
    a = red[0] + red[4] + red[8] + red[12]; b = red[1] + red[5] + red[9] + red[13];
    c = red[2] + red[6] + red[10] + red[14]; d = red[3] + red[7] + red[11] + red[15];
}

DI void glds16(const void* base, unsigned voff, unsigned lds_dst) {
    unsigned keep;
    asm volatile("s_nop 4\n\ts_mov_b32 %0, m0\n\ts_mov_b32 m0, %3\n\ts_nop 0\n\tglobal_load_lds_dwordx4 %1, %2\n\ts_mov_b32 m0, %0" : "=&s"(keep) : "v"(voff), "s"(base), "s"(lds_dst) : "memory");
}
DI int perm32(int rho) { const int n = rho >> 4, i = rho & 15; return 8 * (i >> 2) + 4 * n + (i & 3); }
DI int brow_src(int rr) { return (rr & ~31) + perm32(rr & 31); }
DI const bf16_t* uniform_ptr(const bf16_t* q) {
    const unsigned long long v = (unsigned long long)q;
    const unsigned lo = (unsigned)__builtin_amdgcn_readfirstlane((int)(unsigned)v), hi = (unsigned)__builtin_amdgcn_readfirstlane((int)(unsigned)(v >> 32));
    return (const bf16_t*)(((unsigned long long)hi << 32) | lo);
}
template <int NF, class ARowF>
DI void gemm_prestage(const bf16_t* __restrict__ Abase, ARowF arow, const bf16_t* __restrict__ Bt, int ldb, LAS char* smem) {
    const int t = tidx(), lane = t & 63, wave = t >> 6, lrow = lane >> 3, lch = (lane & 7) ^ lrow;
    const unsigned ldsw = (unsigned)__builtin_amdgcn_readfirstlane((int)((unsigned)(size_t)smem + wave * 1024));
    const bf16_t* Au = uniform_ptr(Abase); const bf16_t* Bu = uniform_ptr(Bt);
#pragma unroll
    for (int i = 0; i < 4; ++i) glds16(Au, ((unsigned)arow((wave + 4 * i) * 8 + lrow) + lch * 8) * 2, ldsw + i * 4096);
#pragma unroll
    for (int i = 0; i < NF; ++i) glds16(Bu, (unsigned)(brow_src((wave + 4 * i) * 8 + lrow) * ldb + lch * 8) * 2, ldsw + 16384 + i * 4096);
}
struct NoNext { DI void operator()() const {} };
template <bool PIPE = true, int NF, class ARowF, class BRowF, class NextF = NoNext>
DI void gemm_tile_g(f32x4 (&acc)[4][NF], const bf16_t* __restrict__ Abase, ARowF arow, const bf16_t* __restrict__ Bt, BRowF brow, int K, LAS char* smem, bool pre = false, NextF next = NextF()) {
    const int t = tidx(), lane = t & 63, wave = t >> 6, wr = wave >> 1, wc = wave & 1, fr = lane & 15, fq = lane >> 4;
    const int lrow = lane >> 3, lch = (lane & 7) ^ lrow;
    unsigned ao[4], bo[NF];
#pragma unroll
    for (int i = 0; i < 4; ++i) ao[i] = ((unsigned)arow((wave + 4 * i) * 8 + lrow) + lch * 8) * 2;
#pragma unroll
    for (int i = 0; i < NF; ++i) bo[i] = ((unsigned)brow((wave + 4 * i) * 8 + lrow) + lch * 8) * 2;
    const unsigned ldsw = (unsigned)__builtin_amdgcn_readfirstlane((int)((unsigned)(size_t)smem + wave * 1024));
    const bf16_t* Au = uniform_ptr(Abase); const bf16_t* Bu = uniform_ptr(Bt);
    auto stage = [&](int buf, int k0) {
        const unsigned dA = ldsw + buf * 32768, dB = dA + 16384;
#pragma unroll
        for (int i = 0; i < 4; ++i) glds16(Au + k0, ao[i], dA + i * 4096);
#pragma unroll
        for (int i = 0; i < NF; ++i) glds16(Bu + k0, bo[i], dB + i * 4096);
    };
    __syncthreads();
    if (!pre) stage(0, 0);
    asm volatile("s_waitcnt vmcnt(0)" ::: "memory");
    __syncthreads();
    const int nk = K >> 6;
    const int sw = (fq ^ (fr & 7)) * 16;
    const int aoff0 = (wr * 64 + fr) * 128 + sw, boff0 = (wc * 16 * NF + fr) * 128 + sw + 16384;
    bf16x8 af0[4], bf0[NF], af1[4], bf1[NF];
    auto ldfrag = [&](const LAS char* sA, int kk, bf16x8 (&af)[4], bf16x8 (&bf)[NF]) {
        const LAS char* pa = sA + (kk ? (aoff0 ^ 64) : aoff0); const LAS char* pb_ = sA + (kk ? (boff0 ^ 64) : boff0);
#pragma unroll
        for (int m = 0; m < 4; ++m) af[m] = *(const LAS bf16x8*)(pa + m * 2048);
#pragma unroll
        for (int n = 0; n < NF; ++n) bf[n] = *(const LAS bf16x8*)(pb_ + n * 2048);
    };
    auto mma = [&](const bf16x8 (&af)[4], const bf16x8 (&bf)[NF]) {
#pragma unroll
        for (int m = 0; m < 4; ++m)
#pragma unroll
            for (int n = 0; n < NF; ++n) acc[m][n] = __builtin_amdgcn_mfma_f32_16x16x32_bf16(bf[n], af[m], acc[m][n], 0, 0, 0);
    };
    if (nk > 1) stage(1, 64);
    if (!PIPE) {
        for (int kt = 0; kt < nk; ++kt) {
            const LAS char* sA = smem + (kt & 1) * 32768;
            ldfrag(sA, 0, af0, bf0); mma(af0, bf0);
            ldfrag(sA, 1, af0, bf0); mma(af0, bf0);
            asm volatile("s_waitcnt vmcnt(0)" ::: "memory");
            __syncthreads();
            if (kt + 2 < nk) stage(kt & 1, (kt + 2) * 64); else if (kt + 2 == nk) next();
        }
        return;
    }
    ldfrag(smem, 0, af0, bf0);
    for (int kt = 0; kt < nk; ++kt) {
        const LAS char* sA = smem + (kt & 1) * 32768;
        ldfrag(sA, 1, af1, bf1);
        mma(af0, bf0);
        asm volatile("s_waitcnt vmcnt(0)" ::: "memory");
        __syncthreads();
        if (kt + 2 < nk) stage(kt & 1, (kt + 2) * 64); else if (kt + 2 == nk) next();
        if (kt + 1 < nk) ldfrag(smem + ((kt + 1) & 1) * 32768, 0, af0, bf0);
        mma(af1, bf1);
    }
}
template <bool PIPE = true, int NF, class ARowF, class NextF = NoNext>
DI void gemm_tile(f32x4 (&acc)[4][NF], const bf16_t* __restrict__ Abase, ARowF arow, const bf16_t* __restrict__ Bt, int ldb, int K, LAS char* smem, bool pre = false, NextF next = NextF()) {
    gemm_tile_g<PIPE>(acc, Abase, arow, Bt, [&](int rr) { return brow_src(rr) * ldb; }, K, smem, pre, next);
}
template <int NF>
DI void zero_acc(f32x4 (&acc)[4][NF]) {
#pragma unroll
    for (int m = 0; m < 4; ++m)
#pragma unroll
        for (int n = 0; n < NF; ++n) acc[m][n] = (f32x4){0.f, 0.f, 0.f, 0.f};
}
template <int NF, class F>
DI void for_frags(const f32x4 (&acc)[4][NF], F f) {
    const int t = tidx(), lane = t & 63, wave = t >> 6, wr = wave >> 1, wc = wave & 1, fr = lane & 15, fq = lane >> 4;
#pragma unroll
    for (int m = 0; m < 4; ++m)
#pragma unroll
        for (int k = 0; k < NF / 2; ++k) f(wr * 64 + m * 16 + fr, wc * 16 * NF + k * 32 + fq * 8, acc[m][2 * k], acc[m][2 * k + 1]);
}
DI f32x4 ld_bf4(const bf16_t* src) { const u32x2 raw = *(const u32x2*)src; f32x4 r; r[0] = __uint_as_float(raw[0] << 16); r[1] = __uint_as_float(raw[0] & 0xffff0000u); r[2] = __uint_as_float(raw[1] << 16); r[3] = __uint_as_float(raw[1] & 0xffff0000u); return r; }
DI void store_bf8(bf16_t* dst, f32x4 lo, f32x4 hi) { u32x4 o; o[0] = pack2(lo[0], lo[1]); o[1] = pack2(lo[2], lo[3]); o[2] = pack2(hi[0], hi[1]); o[3] = pack2(hi[2], hi[3]); *(u32x4*)dst = o; }
DI void store_bf4(bf16_t* dst, f32x4 v) { u32x2 o; o[0] = pack2(v[0], v[1]); o[1] = pack2(v[2], v[3]); *(u32x2*)dst = o; }

struct TJob { const float* src; bf16_t* dst; int K, N, nscale; };
constexpr int NJOBS = 59;
DI TJob get_job(const Params& p, int l, int j) {
    TJob r; r.nscale = 1 << 30;
    if (j == 0) { r.src = p.w_in + (size_t)l * DM * INC; r.dst = p.WinT; r.K = DM; r.N = INC; r.nscale = OFF_GATE; }
    else if (j < 5) { const int i = j - 1; r.src = p.w_branch + ((size_t)l * 4 + i) * 256 * DM; r.dst = p.WbrT + (size_t)i * DM * 256; r.K = 256; r.N = DM; }
    else if (j == 5) { r.src = p.w_out + (size_t)l * DM * DM; r.dst = p.WoutT; r.K = DM; r.N = DM; }
    else if (j < 23) { const int e = j - 6; r.src = e < 16 ? p.moe_w1 + ((size_t)l * 16 + e) * DM * 256 : p.sh_w1 + (size_t)l * DM * 256; r.dst = p.W1T + (size_t)e * 256 * DM; r.K = DM; r.N = 256; }
    else if (j < 40) { const int e = j - 23; r.src = e < 16 ? p.moe_w3 + ((size_t)l * 16 + e) * DM * 256 : p.sh_w3 + (size_t)l * DM * 256; r.dst = p.W3T + (size_t)e * 256 * DM; r.K = DM; r.N = 256; }
    else if (j < 57) { const int e = j - 40; r.src = e < 16 ? p.moe_w2 + ((size_t)l * 16 + e) * 256 * DM : p.sh_w2 + (size_t)l * 256 * DM; r.dst = p.W2T + (size_t)e * DM * 256; r.K = 256; r.N = DM; }
    else if (j == 57) { r.src = p.mla_w_uq + (size_t)l * 256 * 384; r.dst = p.WuqT; r.K = 256; r.N = 384; }
    else { r.src = p.mla_w_ukv + (size_t)l * 128 * 512; r.dst = p.WukvT; r.K = 128; r.N = 512; }
    return r;
}
DI void ph_convert(const Params& p, int l, LAS char* smem) {
    LAS float* tile = (LAS float*)smem;
    const int t = tidx(), G = gdim();
    int base = 0;
    for (int j = 0; j < NJOBS; ++j) {
        const TJob jb = get_job(p, l, j);
        const int tn = (jb.N + 63) / 64, nt = (jb.K / 64) * tn;
        const int first = (int)(((long)bidx() - base) % G + G) % G;
        for (int ti = first; ti < nt; ti += G) {
            const int k0 = (ti / tn) * 64, n0 = (ti % tn) * 64;
            __syncthreads();
            f32x4 ld[4];
#pragma unroll
            for (int i = 0; i < 4; ++i) { const int kr = (t >> 4) + 16 * i, nc = (t & 15) * 4; ld[i] = (n0 + nc < jb.N) ? *(const f32x4*)(jb.src + (size_t)(k0 + kr) * jb.N + n0 + nc) : (f32x4){0.f, 0.f, 0.f, 0.f}; }
#pragma unroll
            for (int i = 0; i < 4; ++i) { const int kr = (t >> 4) + 16 * i, nc = (t & 15) * 4;
#pragma unroll
                for (int q = 0; q < 4; ++q) tile[kr * 65 + nc + q] = ld[i][q]; }
            __syncthreads();
#pragma unroll
            for (int i = 0; i < 2; ++i) { const int c = t + 256 * i, nr = c >> 3, kc = (c & 7) * 8; const float sc = (n0 + nr >= jb.nscale) ? -1.4426950408889634f : 1.f;
                u32x4 o;
#pragma unroll
                for (int q = 0; q < 4; ++q) o[q] = pack2(tile[(kc + 2 * q) * 65 + nr] * sc, tile[(kc + 2 * q + 1) * 65 + nr] * sc);
                if (n0 + nr < jb.N) *(u32x4*)(jb.dst + (size_t)(n0 + nr) * jb.K + k0 + kc) = o; }
        }
        base += nt;
    }
    for (int i = bidx() * NTHR + t; i < 4 * 128 * 128 / 4; i += G * NTHR) store_bf4(p.SGW + (size_t)i * 4, *(const f32x4*)(p.sg_w + (size_t)l * 4 * 128 * 128 + (size_t)i * 4));
}

DI void ph_rot_table(const Params& p) {
    for (int i = bidx() * NTHR + tidx(); i < SEQ * 32; i += gdim() * NTHR) { const int n = i >> 5, d = i & 31;
        float sn, cs; sincosf((float)n * exp2f(-(float)d * (13.287712379549449f / 32.f)), &sn, &cs); p.ROT[2 * i] = cs; p.ROT[2 * i + 1] = sn; }
    for (int i = bidx() * NTHR + tidx(); i < 128 * 8; i += gdim() * NTHR) { float sn, cs; sincosf((float)(i >> 3) * exp2f(-(float)(i & 7) * (13.287712379549449f / 8.f)), &sn, &cs);
        p.ROT[(size_t)SEQ * 64 + 2 * i] = cs; p.ROT[(size_t)SEQ * 64 + 2 * i + 1] = sn; }
}
DI void ph_adaln(const Params& p, LAS char* smem) {
    LAS float* sc = (LAS float*)smem;
    LAS float* red = sc + 5 * DM;
    const int t = tidx();
    for (int i = t; i < 5 * DM; i += NTHR) { const int r = i / DM, k = i % DM; const float v = r < 4 ? p.c[r * DM + k] : p.c_ctx[k]; sc[i] = siluf(v); }
    __syncthreads();
    for (int u = bidx(); u < 2 * 96; u += gdim()) {
        const int l = u / 96, cg = u % 96, col = cg * 64 + (t & 63), kg = t >> 6;
        float a[5] = {0.f, 0.f, 0.f, 0.f, 0.f};
        const float* w = p.w_ada + (size_t)l * DM * 6 * DM + col;
        for (int k = kg * 256; k < kg * 256 + 256; k += 16) { float wv[16];
#pragma unroll
            for (int kk = 0; kk < 16; ++kk) wv[kk] = w[(size_t)(k + kk) * 6 * DM];
#pragma unroll
            for (int kk = 0; kk < 16; ++kk)
#pragma unroll
                for (int r = 0; r < 5; ++r) a[r] += sc[r * DM + k + kk] * wv[kk]; }
        __syncthreads();
#pragma unroll
        for (int r = 0; r < 5; ++r) red[(kg * 5 + r) * 64 + (t & 63)] = a[r];
        __syncthreads();
        if (kg == 0) {
#pragma unroll
            for (int r = 0; r < 5; ++r) { const float s = red[(0 * 5 + r) * 64 + t] + red[(1 * 5 + r) * 64 + t] + red[(2 * 5 + r) * 64 + t] + red[(3 * 5 + r) * 64 + t];
                p.mod[((size_t)l * 5 + r) * 6 * DM + col] = s + p.b_ada[(size_t)l * 6 * DM + col]; }
        }
    }
}

DI const float* xrow_src(const Params& p, int l, int tok) {
    const int b = tok_b(tok), s = tok_s(tok);
    if (s < CTXL) return (l == 0 ? p.ctx : p.xc) + ((size_t)b * CTXL + s) * DM;
    return (l == 0 ? p.x : p.out) + ((size_t)b * SEQ + (s - CTXL)) * DM;
}
DI float* xrow_dst(const Params& p, int tok) {
    const int b = tok_b(tok), s = tok_s(tok);
    if (s < CTXL) return p.xc + ((size_t)b * CTXL + s) * DM;
    return p.out + ((size_t)b * SEQ + (s - CTXL)) * DM;
}
DI const float* mod_row(const Params& p, int l, int tok, int i) { const int b = tok_b(tok), s = tok_s(tok); const int r = s < CTXL ? 4 : b; return p.mod + (((size_t)l * 5 + r) * 6 + i) * DM; }

DI void ph_norm1(const Params& p, int l) {
    const int lane = tidx() & 63, gw = bidx() * 4 + (tidx() >> 6), nw = gdim() * 4;
    if (bidx() == 0 && tidx() < 32) p.cnt[tidx()] = 0;
    const float* g = p.g_pre1 + (size_t)l * DM;
    f32x4 v[4], v1[4], v2[4];
    auto ldrow = [&](int tok, f32x4 (&d)[4]) { if (tok < NT) { const float* src = xrow_src(p, l, tok);
#pragma unroll
        for (int i = 0; i < 4; ++i) d[i] = *(const f32x4*)(src + lane * 4 + 256 * i); } };
    ldrow(gw, v); ldrow(gw + nw, v1);
    for (int tok = gw; tok < NT; tok += nw) {
        ldrow(tok + 2 * nw, v2);
        const float* sh = mod_row(p, l, tok, 0); const float* scl = mod_row(p, l, tok, 1);
        float ss = 0.f;
#pragma unroll
        for (int i = 0; i < 4; ++i) ss += v[i][0] * v[i][0] + v[i][1] * v[i][1] + v[i][2] * v[i][2] + v[i][3] * v[i][3];
        ss = wave_sum(ss); const float rstd = rsqrtf(ss * (1.f / DM) + EPS);
#pragma unroll
        for (int i = 0; i < 4; ++i) { const int d = lane * 4 + 256 * i; const f32x4 gg = *(const f32x4*)(g + d), s1 = *(const f32x4*)(scl + d), s0 = *(const f32x4*)(sh + d);
            f32x4 o;
#pragma unroll
            for (int j = 0; j < 4; ++j) o[j] = v[i][j] * rstd * gg[j] * (1.f + s1[j]) + s0[j];
            store_bf4(p.H + (size_t)tok * DM + d, o); }
#pragma unroll
        for (int i = 0; i < 4; ++i) { v[i] = v1[i]; v1[i] = v2[i]; }
    }
}

struct TileDeal { int x, lb, gl, R, nn, total; };
DI TileDeal deal_init(int nm, int nn) { TileDeal d; const int b = bidx(), g = gdim(); d.x = b & 7; d.lb = b >> 3; d.gl = g >> 3; d.R = nm >> 3; d.nn = nn; d.total = d.R * nn; return d; }
DI void deal_map(const TileDeal& d, int j, int& mt, int& nt) {
    const int bs = 8 * d.nn; const int band = j / bs, jj = j - band * bs;
    nt = jj >> 3; const int lt = d.x * d.R + band * 8 + (jj & 7);
    mt = (lt >> 6) * NCHUNK + 2 + (lt & 63);
}
DI int ctx_mt(int c8) { return (c8 >> 1) * NCHUNK + (c8 & 1); }
template <int NF, class NextF = NoNext>
DI void inproj_unit(const Params& p, int mt, int nt, LAS char* smem, bool pre = false, NextF next = NextF()) {
    f32x4 acc[4][NF]; zero_acc(acc);
    const bf16_t* A = p.H + (size_t)mt * 128 * DM;
    gemm_tile(acc, A, [&](int r) { return r * DM; }, p.WinT + (size_t)nt * 32 * NF * DM, DM, DM, smem, pre, next);
    for_frags(acc, [&](int r, int c, f32x4 lo, f32x4 hi) { const int col = nt * 32 * NF + c; const size_t row = (size_t)mt * 128 + r;
        if (col < 1536) store_bf8(p.P + row * PW + col, lo, hi);
        else if (col < 2304) store_bf8(p.DNRAW + row * 768 + (col - 1536), lo, hi);
        else if (col < PWFULL) store_bf8(p.P + row * PW + (col - 768), lo, hi); });
}
DI void ph_inproj(const Params& p, LAS char* smem) {
    const TileDeal dl = deal_init(256, 24);
    bool pre = false;
    for (int j = dl.lb; j < dl.total; j += dl.gl) { int mt, nt; deal_map(dl, j, mt, nt);
        const int jn = j + dl.gl; const bool hasn = jn < dl.total; int mtn = 0, ntn = 0; if (hasn) deal_map(dl, jn, mtn, ntn);
        inproj_unit<4>(p, mt, nt, smem, pre, [&]() { if (hasn) gemm_prestage<4>(p.H + (size_t)mtn * 128 * DM, [&](int r) { return r * DM; }, p.WinT + (size_t)ntn * 128 * DM, DM, smem); });
        pre = hasn; }
    for (int u = bidx(); u < 8 * 47; u += gdim()) inproj_unit<2>(p, ctx_mt(u / 47), u % 47, smem);
}

DI float xsum16(float v) { v += __shfl_xor(v, 1, 64); v += __shfl_xor(v, 2, 64); v += __shfl_xor(v, 4, 64); v += __shfl_xor(v, 8, 64); return v; }
struct PrepRaw {
    unsigned qa[2], qb[2]; f32x4 cs; u32x2 sgu, sgv, cq; unsigned kvr, rk1, rk2, gate; float rc, rs; u32x2 cv[3][5];
};
DI void ph_prep(const Params& p, int l, LAS char* smem, bool dry = false) {
    (void)smem;
    const int lane = tidx() & 63, gw = bidx() * 4 + (tidx() >> 6), nw = gdim() * 4;
    const int c4 = lane * 4;
    const f32x4 sgg = *(const f32x4*)(p.sg_norm_g + l * 256 + c4), qng = *(const f32x4*)(p.mla_q_norm_g + l * 256 + c4);
    const float kvg0 = p.mla_kv_norm_g[l * 128 + lane * 2], kvg1 = p.mla_kv_norm_g[l * 128 + lane * 2 + 1];
    const int rd = 2 * (lane & 15);
    const float inv8 = exp2f(-(float)(lane & 7) * (13.287712379549449f / 8.f));
    auto load = [&](int tok, PrepRaw& r) {
        const int s = tok_s(tok); const bool isctx = s < CTXL; const int n = s - CTXL;
        const bf16_t* pr = p.P + (size_t)tok * PW;
        r.cs = (f32x4){1.f, 0.f, 1.f, 0.f};
        if (!isctx) r.cs = *(const f32x4*)(p.ROT + ((size_t)n * 32 + rd) * 2);
#pragma unroll
        for (int which = 0; which < 2; ++which) { const bf16_t* qi = pr + which * 256 + (lane >> 4) * 64 + rd; r.qa[which] = *(const unsigned*)qi; r.qb[which] = *(const unsigned*)(qi + 32); }
        r.sgu = *(const u32x2*)(pr + OFF_SG + c4); r.sgv = *(const u32x2*)(pr + OFF_SG + 256 + c4);
        r.cq = *(const u32x2*)(pr + OFF_MLA + c4); r.kvr = *(const unsigned*)(pr + OFF_MLA + 256 + lane * 2);
        r.rk1 = 0u; r.rk2 = 0u; r.gate = 0u; r.rc = 1.f; r.rs = 0.f;
        if (lane < 16 && !isctx) { const int part = lane >> 3, i = lane & 7; const float* t8 = p.ROT + (size_t)SEQ * 64 + ((part == 0 ? (n >> 6) : (n & 63)) * 8 + i) * 2; r.rc = t8[0]; r.rs = t8[1]; }
        if (lane < 16) { const int part = lane >> 3, i = lane & 7; r.rk1 = pr[OFF_MLA + 384 + part * 16 + i]; r.rk2 = pr[OFF_MLA + 384 + part * 16 + i + 8]; r.gate = pr[OFF_DNZ + 256 + lane]; }
        const int pos = isctx ? s : n, len = isctx ? CTXL : SEQ;
#pragma unroll
        for (int j = 0; j < 3; ++j)
#pragma unroll
            for (int i = 0; i < 5; ++i) { const int ps = pos + i - 2; r.cv[j][i] = (u32x2){0u, 0u};
                if (ps >= 0 && ps < len) r.cv[j][i] = *(const u32x2*)(p.DNRAW + (size_t)(tok + i - 2) * 768 + c4 + 256 * j); }
    };
    auto up = [](u32x2 r) { f32x4 o; o[0] = __uint_as_float(r[0] << 16); o[1] = __uint_as_float(r[0] & 0xffff0000u); o[2] = __uint_as_float(r[1] << 16); o[3] = __uint_as_float(r[1] & 0xffff0000u); return o; };
    const float negA = lane < 8 ? -expf(p.dn_A_log[l * 8 + lane]) : 0.f, dtb = lane < 8 ? p.dn_dt_bias[l * 8 + lane] : 0.f;
    PrepRaw cur, nxt;
    if (gw < NT) load(gw, cur);
    for (int tok = gw; tok < NT; tok += nw) {
        if (tok + nw < NT) load(tok + nw, nxt);
        const int b = tok_b(tok), s = tok_s(tok); const bool isctx = s < CTXL; const int n = s - CTXL;
        bf16_t* pw = dry ? p.Y + (size_t)(tok & 8191) * PW : p.P + (size_t)tok * PW;
        {
            const float c0 = cur.cs[0], s0 = cur.cs[1], c1 = cur.cs[2], s1 = cur.cs[3];
#pragma unroll
            for (int which = 0; which < 2; ++which) {
                bf16_t* q = pw + which * 256 + (lane >> 4) * 64 + rd;
                const unsigned a = cur.qa[which], bq = cur.qb[which];
                const float x10 = __uint_as_float(a << 16), x11 = __uint_as_float(a & 0xffff0000u), x20 = __uint_as_float(bq << 16), x21 = __uint_as_float(bq & 0xffff0000u);
                const float sc = which ? 0.125f : 1.f;
                *(unsigned*)q = pack2((x10 * c0 - x20 * s0) * sc, (x11 * c1 - x21 * s1) * sc);
                *(unsigned*)(q + 32) = pack2((x20 * c0 + x10 * s0) * sc, (x21 * c1 + x11 * s1) * sc);
            }
        }
        {
            const f32x4 u = up(cur.sgu), v = up(cur.sgv); f32x4 gu, gv;
#pragma unroll
            for (int j = 0; j < 4; ++j) { gu[j] = gelu_tanh(u[j]); gv[j] = gelu_tanh(v[j]); }
            const float mean = wave_sum(gv[0] + gv[1] + gv[2] + gv[3]) * (1.f / 256.f);
            f32x4 d; float vs = 0.f;
#pragma unroll
            for (int j = 0; j < 4; ++j) { d[j] = gv[j] - mean; vs += d[j] * d[j]; }
            const float rstd = rsqrtf(wave_sum(vs) * (1.f / 256.f) + EPS);
#pragma unroll
            for (int j = 0; j < 4; ++j) d[j] = d[j] * rstd * sgg[j];
            store_bf4(pw + OFF_SG + c4, gu); store_bf4(pw + OFF_SG + 256 + c4, d);
        }
        {
            f32x4 cq = up(cur.cq);
            const unsigned kvr = cur.kvr;
            float k0 = __uint_as_float(kvr << 16), k1 = __uint_as_float(kvr & 0xffff0000u);
            const float rq = rsqrtf(wave_sum(cq[0] * cq[0] + cq[1] * cq[1] + cq[2] * cq[2] + cq[3] * cq[3]) * (1.f / 256.f) + EPS);
            const float rk = rsqrtf(wave_sum(k0 * k0 + k1 * k1) * (1.f / 128.f) + EPS);
#pragma unroll
            for (int j = 0; j < 4; ++j) cq[j] = cq[j] * rq * qng[j];
            store_bf4(pw + OFF_MLA + c4, cq);
            *(unsigned*)(pw + OFF_MLA + 256 + lane * 2) = pack2(k0 * rk * kvg0, k1 * rk * kvg1);
        }
        if (lane < 16 && !dry) {
            const int part = lane >> 3, i = lane & 7;
            const float x1 = bf2f((bf16_t)cur.rk1), x2 = bf2f((bf16_t)cur.rk2); float y1 = x1, y2 = x2;
            if (!isctx) { const float cs = cur.rc, sn = cur.rs; y1 = x1 * cs - x2 * sn; y2 = x2 * cs + x1 * sn; }
#pragma unroll
            for (int hh = 0; hh < 4; ++hh) { bf16_t* kd = p.MK + (((size_t)b * 4 + hh) * SU + s) * 96 + 64 + part * 16 + i; kd[0] = f2bf(y1); kd[8] = f2bf(y2); }
        }
        if (dry) {} else if (lane < 8) { const float a = bf2f((bf16_t)cur.gate); p.DG[(size_t)tok * 8 + lane] = negA * softplusf_(a + dtb); }
        else if (lane < 16) { p.DB[(size_t)tok * 8 + (lane - 8)] = sigmoidf_(bf2f((bf16_t)cur.gate)); }
        {
#pragma unroll
            for (int j = 0; j < 3; ++j) {
                const int c = c4 + 256 * j; f32x4 a = (f32x4){0.f, 0.f, 0.f, 0.f};
#pragma unroll
                for (int i = 0; i < 5; ++i) { const f32x4 xv = up(cur.cv[j][i]), wv = *(const f32x4*)(p.dn_conv_w + ((size_t)l * 5 + i) * 768 + c); a += xv * wv; }
                float ssq = 0.f;
#pragma unroll
                for (int jj = 0; jj < 4; ++jj) { a[jj] = siluf(a[jj]); ssq += a[jj] * a[jj]; }
                if (j < 2) { const float sc = rsqrtf(xsum16(ssq) + EPS) * (j == 0 ? 0.125f : 1.f); a *= sc; }
                store_bf4((dry ? p.Y + (size_t)8192 * PW + (size_t)(tok & 8191) * 768 : p.DNQKV + (size_t)tok * 768) + c, a);
            }
        }
        cur = nxt;
    }
}

DI void ph_mla_up_unit(const Params& p, int u, LAS char* smem) {
    const float qscale = 0.10206207261596575f * 1.4426950408889634f;
    {
        const int mt = u / 7, j = u % 7;
        f32x4 acc[4][4]; zero_acc(acc);
        if (j < 3) {
            const bf16_t* A = p.P + (size_t)mt * 128 * PW + OFF_MLA;
            gemm_tile(acc, A, [&](int r) { return r * PW; }, p.WuqT + (size_t)j * 128 * 256, 256, 256, smem);
            for_frags(acc, [&](int r, int c, f32x4 lo, f32x4 hi) { const int tok = mt * 128 + r, col = j * 128 + c, hh = col / 96, d = col % 96;
                store_bf8(p.MQ + (((size_t)tok_b(tok) * 4 + hh) * SU + tok_s(tok)) * 96 + d, lo * qscale, hi * qscale); });
        } else {
            const int hh = j - 3;
            const bf16_t* A = p.P + (size_t)mt * 128 * PW + OFF_MLA + 256;
            gemm_tile(acc, A, [&](int r) { return r * PW; }, p.WukvT + (size_t)hh * 128 * 128, 128, 128, smem);
            for_frags(acc, [&](int r, int c, f32x4 lo, f32x4 hi) { const int tok = mt * 128 + r, b = tok_b(tok), s = tok_s(tok);
                if (c < 64) store_bf8(p.MK + (((size_t)b * 4 + hh) * SU + s) * 96 + c, lo, hi);
                else { const int sp = (s & ~15) | (s & 3) | ((s & 4) << 1) | ((s & 8) >> 1);
                    bf16_t* d = p.MVT + (((size_t)b * 4 + hh) * 64 + (c - 64)) * SU + sp;
                    d[0] = f2bf(lo[0]); d[SU] = f2bf(lo[1]); d[2 * SU] = f2bf(lo[2]); d[3 * SU] = f2bf(lo[3]); d[4 * SU] = f2bf(hi[0]); d[5 * SU] = f2bf(hi[1]); d[6 * SU] = f2bf(hi[2]); d[7 * SU] = f2bf(hi[3]); } });
        }
    }
}

DI float rdl(float v, int i) { return __int_as_float(__builtin_amdgcn_readlane(__float_as_int(v), i)); }
DI void ph_scan(const Params& p, int l) {
    const int lane = tidx() & 63, cid = bidx() * 4 + (tidx() >> 6);
    if (cid >= 64) return;
    const int kind = cid >> 5, b = (cid >> 3) & 3, hh = (cid >> 1) & 3, dir = cid & 1;
    if ((kind == 0 && RET_NEW) || (kind == 1 && DN_NEW)) return;
    float S[64];
#pragma unroll
    for (int i = 0; i < 64; ++i) S[i] = 0.f;
    const float gam = kind == 0 ? sigmoidf_(p.ret_logit[l * 8 + dir * 4 + hh]) : 0.f;
    for (int i = 0; i < SU; ++i) {
        const int s = dir == 0 ? i : (i < CTXL ? CTXL - 1 - i : SU - 1 - (i - CTXL));
        const size_t tok = (size_t)b * SU + s;
        float q, k, v, o = 0.f;
        if (kind == 0) {
            const bf16_t* pr = p.P + tok * PW + hh * 64 + lane;
            q = bf2f(pr[0]); k = bf2f(pr[256]); v = bf2f(pr[512]);
            if (dir == 0) {
#pragma unroll
                for (int d = 0; d < 64; ++d) { S[d] = gam * S[d] + rdl(k, d) * v; o += rdl(q, d) * S[d]; }
            } else {
#pragma unroll
                for (int d = 0; d < 64; ++d) { S[d] = gam * S[d]; o += rdl(q, d) * S[d]; S[d] += rdl(k, d) * v; }
            }
            p.Y[tok * DM + dir * 256 + hh * 64 + lane] = f2bf(o);
        } else {
            const bf16_t* pr = p.DNQKV + tok * 768 + hh * 64 + lane;
            q = bf2f(pr[0]); k = bf2f(pr[256]); v = bf2f(pr[512]);
            const float g = p.DG[tok * 8 + dir * 4 + hh], beta = p.DB[tok * 8 + dir * 4 + hh], eg = __expf(g);
            float kS = 0.f;
#pragma unroll
            for (int d = 0; d < 64; ++d) kS += rdl(k, d) * S[d];
            const float dd = beta * (v - eg * kS);
#pragma unroll
            for (int d = 0; d < 64; ++d) { S[d] = eg * S[d] + rdl(k, d) * dd; o += rdl(q, d) * S[d]; }
            p.Y[tok * DM + 512 + dir * 256 + hh * 64 + lane] = f2bf(o);
        }
    }
}

DI void ph_fin(const Params& p, int l) {
    const int lane = tidx() & 63, gw = bidx() * 4 + (tidx() >> 6), nw = gdim() * 4;
    for (int tok = gw; tok < NT; tok += nw) {
        bf16_t* y = p.Y + (size_t)tok * DM; const bf16_t* pr = p.P + (size_t)tok * PW;
#pragma unroll
        for (int hh = 0; hh < 4; ++hh) {
            const int c = hh * 64 + lane;
            if (!RET_NEW) { const float o = bf2f(y[c]) + bf2f(y[256 + c]); const float mean = wave_sum(o) * (1.f / 64.f), d = o - mean; const float var = wave_sum(d * d) * (1.f / 64.f);
              y[c] = f2bf(d * rsqrtf(var + EPS) * siluf(bf2f(pr[768 + c]))); }
            if (!DN_NEW) { const float o2 = bf2f(y[512 + c]) + bf2f(y[768 + c]); const float ms = wave_sum(o2 * o2) * (1.f / 64.f);
              y[512 + c] = f2bf(o2 * rsqrtf(ms + EPS) * p.dn_norm_g[l * 64 + lane] * siluf(bf2f(pr[OFF_DNZ + c]))); }
        }
    }
}

typedef float f32x2 __attribute__((ext_vector_type(2)));
DI int crow(int reg, int h) { return (reg & 3) + 8 * (reg >> 2) + 4 * h; }
DI bf16x8 pack8(const f32x16& x, int s) {
    u32x4 r; r[0] = pack2(x[8 * s + 0], x[8 * s + 1]); r[1] = pack2(x[8 * s + 2], x[8 * s + 3]); r[2] = pack2(x[8 * s + 4], x[8 * s + 5]); r[3] = pack2(x[8 * s + 6], x[8 * s + 7]);
    return __builtin_bit_cast(bf16x8, r);
}
#define MFMA32(a, b, c) __builtin_amdgcn_mfma_f32_32x32x16_bf16((a), (b), (c), 0, 0, 0)
DI float opaque_zero() { float z; asm volatile("v_mov_b32 %0, 0" : "=v"(z)); return z; }
DI f32x16 zero16() { const float z0 = opaque_zero(); f32x16 z;
#pragma unroll
    for (int i = 0; i < 16; ++i) z[i] = z0;
    return z; }
DI bf16x8 cat4(s16x4 lo, s16x4 hi) { return __builtin_shufflevector(lo, hi, 0, 1, 2, 3, 4, 5, 6, 7); }
DI void rope_q(const float* R8, bf16x8 (&Qf)[6], int n, int h2) {
#pragma unroll
    for (int f = 0; f < 2; ++f) {
        const int posi = f == 0 ? (n >> 6) : (n & 63);
        const u32x4 mine = __builtin_bit_cast(u32x4, Qf[4 + f]); u32x4 oth, res;
#pragma unroll
        for (int q = 0; q < 4; ++q) oth[q] = __shfl_xor(mine[q], 32, 64);
#pragma unroll
        for (int q = 0; q < 4; ++q) {
            const float xa = __uint_as_float(mine[q] << 16), xb = __uint_as_float(mine[q] & 0xffff0000u), ya = __uint_as_float(oth[q] << 16), yb = __uint_as_float(oth[q] & 0xffff0000u);
            const f32x4 cs4 = *(const f32x4*)(R8 + (posi * 8 + 2 * q) * 2); const float ca = cs4[0], sa = cs4[1], cb = cs4[2], sb = cs4[3];
            const float ra = h2 == 0 ? xa * ca - ya * sa : xa * ca + ya * sa, rb = h2 == 0 ? xb * cb - yb * sb : xb * cb + yb * sb;
            res[q] = pack2(ra, rb);
        }
        Qf[4 + f] = __builtin_bit_cast(bf16x8, res);
    }
}
DI float max16(const f32x16& S) {
    return fmaxf(fmaxf(fmaxf(fmaxf(S[0], S[1]), fmaxf(S[2], S[3])), fmaxf(fmaxf(S[4], S[5]), fmaxf(S[6], S[7]))), fmaxf(fmaxf(fmaxf(S[8], S[9]), fmaxf(S[10], S[11])), fmaxf(fmaxf(S[12], S[13]), fmaxf(S[14], S[15]))));
}
DI void attn_unit_classic(const Params& p, int b, int hh, int s0, int nkeys, LAS char* smem) {
    const int t = tidx(), lane = t & 63, w = t >> 6, r = lane & 31, h2 = lane >> 5;
    const bf16_t* Kb = p.MK + ((size_t)b * 4 + hh) * SU * 96;
    const bf16_t* Vb = p.MVT + ((size_t)b * 4 + hh) * 64 * SU;
    const int sqa = s0 + w * 64 + r, sqb = sqa + 32;
    bf16x8 Qa[6], Qb[6];
    { const bf16_t* q = p.MQ + (((size_t)b * 4 + hh) * SU + sqa) * 96 + 8 * h2;
#pragma unroll
      for (int st = 0; st < 6; ++st) { Qa[st] = *(const bf16x8*)(q + 16 * st); Qb[st] = *(const bf16x8*)(q + 32 * 96 + 16 * st); } }
    if (s0 >= CTXL) { rope_q(p.ROT + (size_t)SEQ * 64, Qa, sqa - CTXL, h2); rope_q(p.ROT + (size_t)SEQ * 64, Qb, sqb - CTXL, h2); }
    unsigned ko[4], vo[2];
#pragma unroll
    for (int i = 0; i < 4; ++i) { const int key = (w + 4 * i) * 4 + (lane >> 4); int part = (lane & 15) ^ (key & 15); if (part >= 12) part -= 12; ko[i] = (unsigned)(key * 96 + part * 8) * 2; }
#pragma unroll
    for (int i = 0; i < 2; ++i) { const int dv = (w + 4 * i) * 8 + (lane >> 3); const int ch = (lane & 7) ^ ((dv >> 1) & 7); vo[i] = (unsigned)(dv * SU + ch * 8) * 2; }
    const unsigned ldsw = (unsigned)__builtin_amdgcn_readfirstlane((int)((unsigned)(size_t)smem + w * 1024));
    auto stage = [&](int kt) {
        const unsigned dK = ldsw + (kt & 1) * 24576, dV = dK + 16384;
#pragma unroll
        for (int i = 0; i < 4; ++i) glds16(Kb + (size_t)kt * (64 * 96), ko[i], dK + i * 4096);
#pragma unroll
        for (int i = 0; i < 2; ++i) glds16(Vb + (size_t)kt * 64, vo[i], dV + i * 4096);
    };
    f32x16 Oa0 = zero16(), Oa1 = zero16(), Ob0 = zero16(), Ob1 = zero16();
    float ma = -1e30f, la = 0.f, mb = -1e30f, lb = 0.f;
    const int nkt = nkeys / 64;
    __syncthreads();
    stage(0);
    asm volatile("s_waitcnt vmcnt(0)" ::: "memory");
    __syncthreads();
    const int vsw0 = ((r >> 1) & 7);
    for (int kt = 0; kt < nkt; ++kt) {
        if (kt + 1 < nkt) stage(kt + 1);
        const LAS char* sK = smem + (kt & 1) * 24576; const LAS char* sV = sK + 16384;
#pragma unroll
        for (int sub = 0; sub < 2; ++sub) {
            f32x16 Sa = zero16(), Sb = zero16();
            const int key = sub * 32 + r;
#pragma unroll
            for (int st = 0; st < 6; ++st) { const bf16x8 kf = *(const LAS bf16x8*)(sK + key * 256 + (((st * 2 + h2) ^ (key & 15)) * 16)); Sa = MFMA32(kf, Qa[st], Sa); Sb = MFMA32(kf, Qb[st], Sb); }
            __builtin_amdgcn_sched_barrier(0);
            float mxa = max16(Sa), mxb = max16(Sb);
            mxa = fmaxf(mxa, __shfl_xor(mxa, 32, 64)); mxb = fmaxf(mxb, __shfl_xor(mxb, 32, 64));
            if (__any(mxa > ma + 8.f || mxb > mb + 8.f)) {
                const float na = fmaxf(ma, mxa), nb = fmaxf(mb, mxb), aa = __builtin_amdgcn_exp2f(ma - na), ab = __builtin_amdgcn_exp2f(mb - nb);
                la *= aa; ma = na; lb *= ab; mb = nb;
#pragma unroll
                for (int i = 0; i < 16; ++i) { Oa0[i] *= aa; Oa1[i] *= aa; Ob0[i] *= ab; Ob1[i] *= ab; }
            }
            float pa = 0.f, pbs = 0.f;
#pragma unroll
            for (int i = 0; i < 16; ++i) { Sa[i] = __builtin_amdgcn_exp2f(Sa[i] - ma); Sb[i] = __builtin_amdgcn_exp2f(Sb[i] - mb); pa += Sa[i]; pbs += Sb[i]; }
            la += pa; lb += pbs;
            __builtin_amdgcn_sched_barrier(0);
#pragma unroll
            for (int s2 = 0; s2 < 2; ++s2) {
                const bf16x8 qa = pack8(Sa, s2), qb = pack8(Sb, s2);
                const int c = sub * 4 + 2 * s2;
                const bf16x8 v0 = *(const LAS bf16x8*)(sV + r * 128 + (((c + h2) ^ vsw0) * 16)), v1 = *(const LAS bf16x8*)(sV + (32 + r) * 128 + (((c + h2) ^ vsw0) * 16));
                Oa0 = MFMA32(v0, qa, Oa0); Ob0 = MFMA32(v0, qb, Ob0); Oa1 = MFMA32(v1, qa, Oa1); Ob1 = MFMA32(v1, qb, Ob1);
            }
            __builtin_amdgcn_sched_barrier(0);
        }
        asm volatile("s_waitcnt vmcnt(0)" ::: "memory");
        __syncthreads();
    }
    la += __shfl_xor(la, 32, 64); lb += __shfl_xor(lb, 32, 64);
    const float ia = 1.f / la, ib = 1.f / lb;
    bf16_t* ya = p.Y + ((size_t)b * SU + sqa) * DM + 768 + hh * 64; bf16_t* yb = ya + (size_t)32 * DM;
#pragma unroll
    for (int g = 0; g < 4; ++g) {
        store_bf4(ya + 8 * g + 4 * h2, (f32x4){Oa0[4 * g] * ia, Oa0[4 * g + 1] * ia, Oa0[4 * g + 2] * ia, Oa0[4 * g + 3] * ia});
        store_bf4(ya + 32 + 8 * g + 4 * h2, (f32x4){Oa1[4 * g] * ia, Oa1[4 * g + 1] * ia, Oa1[4 * g + 2] * ia, Oa1[4 * g + 3] * ia});
        store_bf4(yb + 8 * g + 4 * h2, (f32x4){Ob0[4 * g] * ib, Ob0[4 * g + 1] * ib, Ob0[4 * g + 2] * ib, Ob0[4 * g + 3] * ib});
        store_bf4(yb + 32 + 8 * g + 4 * h2, (f32x4){Ob1[4 * g] * ib, Ob1[4 * g + 1] * ib, Ob1[4 * g + 2] * ib, Ob1[4 * g + 3] * ib});
    }
}

DI bool attn_unit(const Params& p, int b, int hh, int s0, int nkeys, LAS char* smem) {
    const int t = tidx(), lane = t & 63, w = t >> 6, r = lane & 31, h2 = lane >> 5;
    const bf16_t* Kb = p.MK + ((size_t)b * 4 + hh) * SU * 96;
    const bf16_t* Vb = p.MVT + ((size_t)b * 4 + hh) * 64 * SU;
    const int sqa = s0 + w * 64 + r, sqb = sqa + 32;
    bf16x8 Qa[6], Qb[6];
    { const bf16_t* q = p.MQ + (((size_t)b * 4 + hh) * SU + sqa) * 96 + 8 * h2;
#pragma unroll
      for (int st = 0; st < 6; ++st) { Qa[st] = *(const bf16x8*)(q + 16 * st); Qb[st] = *(const bf16x8*)(q + 32 * 96 + 16 * st); } }
    if (s0 >= CTXL) { rope_q(p.ROT + (size_t)SEQ * 64, Qa, sqa - CTXL, h2); rope_q(p.ROT + (size_t)SEQ * 64, Qb, sqb - CTXL, h2); }
    unsigned ko[4], vo[2];
#pragma unroll
    for (int i = 0; i < 4; ++i) { const int key = (w + 4 * i) * 4 + (lane >> 4); int part = (lane & 15) ^ (key & 15); if (part >= 12) part -= 12; ko[i] = (unsigned)(key * 96 + part * 8) * 2; }
#pragma unroll
    for (int i = 0; i < 2; ++i) { const int dv = (w + 4 * i) * 8 + (lane >> 3); const int ch = (lane & 7) ^ ((dv >> 1) & 7); vo[i] = (unsigned)(dv * SU + ch * 8) * 2; }
    const unsigned ldsw = (unsigned)__builtin_amdgcn_readfirstlane((int)((unsigned)(size_t)smem + w * 1024));
    auto stage = [&](int kt) {
        const unsigned dK = ldsw + (kt & 1) * 24576, dV = dK + 16384;
#pragma unroll
        for (int i = 0; i < 4; ++i) glds16(Kb + (size_t)kt * (64 * 96), ko[i], dK + i * 4096);
#pragma unroll
        for (int i = 0; i < 2; ++i) glds16(Vb + (size_t)kt * 64, vo[i], dV + i * 4096);
    };
    f32x16 Oa0 = zero16(), Oa1 = zero16(), Ob0 = zero16(), Ob1 = zero16();
    f32x2 la2 = {0.f, 0.f}, lb2 = {0.f, 0.f};
    f32x16 ZT = zero16();
    const int nkt = nkeys / 64;
    __syncthreads();
    stage(0);
    asm volatile("s_waitcnt vmcnt(0)" ::: "memory");
    __syncthreads();
    const int vsw0 = ((r >> 1) & 7);
    for (int kt = 0; kt < nkt; ++kt) {
        if (kt + 1 < nkt) stage(kt + 1);
        const LAS char* sK = smem + (kt & 1) * 24576; const LAS char* sV = sK + 16384;
#pragma unroll
        for (int sub = 0; sub < 2; ++sub) {
            f32x16 Sa, Sb;
            const int key = sub * 32 + r;
            {
                const bf16x8 kf = *(const LAS bf16x8*)(sK + key * 256 + ((h2 ^ (key & 15)) * 16));
                Sa = MFMA32(kf, Qa[0], ZT); Sb = MFMA32(kf, Qb[0], ZT);
            }
#pragma unroll
            for (int st = 1; st < 6; ++st) { const bf16x8 kf = *(const LAS bf16x8*)(sK + key * 256 + (((st * 2 + h2) ^ (key & 15)) * 16)); Sa = MFMA32(kf, Qa[st], Sa); Sb = MFMA32(kf, Qb[st], Sb); }
            __builtin_amdgcn_sched_barrier(0);
#pragma unroll
            for (int i = 0; i < 8; ++i) {
                Sa[2 * i] = __builtin_amdgcn_exp2f(Sa[2 * i]); Sa[2 * i + 1] = __builtin_amdgcn_exp2f(Sa[2 * i + 1]); Sb[2 * i] = __builtin_amdgcn_exp2f(Sb[2 * i]); Sb[2 * i + 1] = __builtin_amdgcn_exp2f(Sb[2 * i + 1]);
                la2 += (f32x2){Sa[2 * i], Sa[2 * i + 1]}; lb2 += (f32x2){Sb[2 * i], Sb[2 * i + 1]};
            }
            __builtin_amdgcn_sched_barrier(0);
#pragma unroll
            for (int s2 = 0; s2 < 2; ++s2) {
                const bf16x8 qa = pack8(Sa, s2), qb = pack8(Sb, s2);
                const int c = sub * 4 + 2 * s2;
                const bf16x8 v0 = *(const LAS bf16x8*)(sV + r * 128 + (((c + h2) ^ vsw0) * 16)), v1 = *(const LAS bf16x8*)(sV + (32 + r) * 128 + (((c + h2) ^ vsw0) * 16));
                Oa0 = MFMA32(v0, qa, Oa0); Ob0 = MFMA32(v0, qb, Ob0); Oa1 = MFMA32(v1, qa, Oa1); Ob1 = MFMA32(v1, qb, Ob1);
            }
            __builtin_amdgcn_sched_barrier(0);
        }
        asm volatile("s_waitcnt vmcnt(0)" ::: "memory");
        __syncthreads();
    }
    float la = la2[0] + la2[1], lb = lb2[0] + lb2[1];
    la += __shfl_xor(la, 32, 64); lb += __shfl_xor(lb, 32, 64);
    bool bad = !(la > 1e-30f) || !(la < 1e33f) || !(lb > 1e-30f) || !(lb < 1e33f);
    const float ia = 1.f / la, ib = 1.f / lb;
    { float ca = 0.f, cb = 0.f;
#pragma unroll
      for (int i = 0; i < 16; ++i) { ca = fmaxf(ca, fmaxf(fabsf(Oa0[i]), fabsf(Oa1[i]))); cb = fmaxf(cb, fmaxf(fabsf(Ob0[i]), fabsf(Ob1[i]))); }
      bad = bad || !(ca * ia < 1e30f) || !(cb * ib < 1e30f); }
    {
        LAS int* flags = (LAS int*)(smem + 49152);
        const bool wbad = __any(bad);
        if (lane == 0) flags[w] = wbad ? 1 : 0;
        __syncthreads();
        if (__builtin_amdgcn_readfirstlane(flags[0] | flags[1] | flags[2] | flags[3])) return true;
    }
    bf16_t* ya = p.Y + ((size_t)b * SU + sqa) * DM + 768 + hh * 64; bf16_t* yb = ya + (size_t)32 * DM;
#pragma unroll
    for (int g = 0; g < 4; ++g) {
        store_bf4(ya + 8 * g + 4 * h2, (f32x4){Oa0[4 * g] * ia, Oa0[4 * g + 1] * ia, Oa0[4 * g + 2] * ia, Oa0[4 * g + 3] * ia});
        store_bf4(ya + 32 + 8 * g + 4 * h2, (f32x4){Oa1[4 * g] * ia, Oa1[4 * g + 1] * ia, Oa1[4 * g + 2] * ia, Oa1[4 * g + 3] * ia});
        store_bf4(yb + 8 * g + 4 * h2, (f32x4){Ob0[4 * g] * ib, Ob0[4 * g + 1] * ib, Ob0[4 * g + 2] * ib, Ob0[4 * g + 3] * ib});
        store_bf4(yb + 32 + 8 * g + 4 * h2, (f32x4){Ob1[4 * g] * ib, Ob1[4 * g + 1] * ib, Ob1[4 * g + 2] * ib, Ob1[4 * g + 3] * ib});
    }
    return false;
}

constexpr int IMG = 136;
DI void sgm_unit(const Params& p, int l, int b, int c, int g, LAS char* smem) {
    LAS bf16_t* VT = (LAS bf16_t*)smem;
    const int t = tidx(), lane = t & 63, w = t >> 6, r = lane & 31, h2 = lane >> 5;
    const size_t tok0 = (size_t)b * SU + c * 128;
    __syncthreads();
    { const int j = t >> 1, half = t & 1; const bf16_t* vr = p.P + (tok0 + j) * PW + OFF_SG + 256 + g * 64 + half * 32;
#pragma unroll
      for (int q4 = 0; q4 < 4; ++q4) { const bf16x8 vv = *(const bf16x8*)(vr + q4 * 8);
#pragma unroll
          for (int e = 0; e < 8; ++e) VT[(half * 32 + q4 * 8 + e) * IMG + j] = (bf16_t)vv[e]; } }
    const int i = 32 * w + r;
    const bf16_t* wrow = p.SGW + ((size_t)g * 128 + i) * 128 + 8 * h2;
    bf16x8 Wf[8];
#pragma unroll
    for (int s8 = 0; s8 < 8; ++s8) Wf[s8] = *(const bf16x8*)(wrow + 16 * s8);
    __syncthreads();
    f32x16 O0 = zero16(), O1 = zero16();
#pragma unroll
    for (int s8 = 0; s8 < 8; ++s8) {
        O0 = MFMA32(*(const LAS bf16x8*)(VT + r * IMG + 16 * s8 + 8 * h2), Wf[s8], O0);
        O1 = MFMA32(*(const LAS bf16x8*)(VT + (32 + r) * IMG + 16 * s8 + 8 * h2), Wf[s8], O1);
    }
    const float bias = p.sg_b[((size_t)l * 4 + g) * 128 + i];
    const bf16_t* ur = p.P + (tok0 + i) * PW + OFF_SG + g * 64 + 4 * h2; bf16_t* y = p.Y + (tok0 + i) * DM + 256 + g * 64 + 4 * h2;
#pragma unroll
    for (int q = 0; q < 4; ++q) {
        const f32x4 u0 = ld_bf4(ur + 8 * q), u1 = ld_bf4(ur + 32 + 8 * q); f32x4 o0, o1;
#pragma unroll
        for (int j = 0; j < 4; ++j) { o0[j] = u0[j] * (O0[4 * q + j] + bias); o1[j] = u1[j] * (O1[4 * q + j] + bias); }
        store_bf4(y + 8 * q, o0); store_bf4(y + 32 + 8 * q, o1);
    }
}

DI size_t st_slot(int b, int h, int dir, int c) { return ((size_t)(((b * 4 + h) * 2 + dir) * NCHUNK + c)) * 4096; }
DI int chunk_of(int dir, int step) { return dir == 0 ? step : (step < 2 ? 1 - step : NCHUNK + 1 - step); }
DI float ret_lg2(const Params& p, int l, int dir, int h) { return -log1pf(expf(-p.ret_logit[l * 8 + dir * 4 + h])) * 1.4426950408889634f; }

DI void retkv_unit(const Params& p, int l, int b, int h, int c, LAS char* smem) {
    LAS bf16_t* KTf = (LAS bf16_t*)smem; LAS bf16_t* KTb = KTf + 64 * IMG; LAS bf16_t* VT = KTb + 64 * IMG;
    const int t = tidx(), lane = t & 63, w = t >> 6, r = lane & 31, h2 = lane >> 5;
    const size_t tok0 = (size_t)b * SU + c * 128;
    const float lgf = ret_lg2(p, l, 0, h), lgb = ret_lg2(p, l, 1, h);
    __syncthreads();
    { const int j = t >> 1, half = t & 1;
      const bf16_t* kr = p.P + (tok0 + j) * PW + 256 + h * 64 + half * 32; const bf16_t* vr = kr + 256;
      const float wf = exp2f((float)(127 - j) * lgf), wb = exp2f((float)j * lgb);
#pragma unroll
      for (int q4 = 0; q4 < 4; ++q4) { const bf16x8 kk = *(const bf16x8*)(kr + q4 * 8), vv = *(const bf16x8*)(vr + q4 * 8);
#pragma unroll
          for (int e = 0; e < 8; ++e) { const int d = half * 32 + q4 * 8 + e; const float kv = bf2f((bf16_t)kk[e]);
              KTf[d * IMG + j] = f2bf(kv * wf); KTb[d * IMG + j] = f2bf(kv * wb); VT[d * IMG + j] = (bf16_t)vv[e]; } } }
    __syncthreads();
    const int dkt = w >> 1, dvt = w & 1;
    f32x16 af = zero16(), ab = zero16();
#pragma unroll
    for (int s = 0; s < 8; ++s) {
        const bf16x8 a_f = *(const LAS bf16x8*)(KTf + (dkt * 32 + r) * IMG + 16 * s + 8 * h2), a_b = *(const LAS bf16x8*)(KTb + (dkt * 32 + r) * IMG + 16 * s + 8 * h2);
        const bf16x8 bv = *(const LAS bf16x8*)(VT + (dvt * 32 + r) * IMG + 16 * s + 8 * h2);
        af = MFMA32(a_f, bv, af); ab = MFMA32(a_b, bv, ab);
    }
    bf16_t* of = p.RS + st_slot(b, h, 0, c) + (dvt * 32 + r) * 64 + dkt * 32 + 4 * h2;
    bf16_t* ob = p.RS + st_slot(b, h, 1, c) + (dvt * 32 + r) * 64 + dkt * 32 + 4 * h2;
#pragma unroll
    for (int g = 0; g < 4; ++g) { store_bf4(of + 8 * g, (f32x4){af[4 * g], af[4 * g + 1], af[4 * g + 2], af[4 * g + 3]}); store_bf4(ob + 8 * g, (f32x4){ab[4 * g], ab[4 * g + 1], ab[4 * g + 2], ab[4 * g + 3]}); }
}

DI void ret_scan(const Params& p, int l, int gid) {
    const int ch = gid >> 11, e2 = gid & 2047, dir = ch & 1, h = (ch >> 1) & 3;
    const float gc = exp2f(128.f * ret_lg2(p, l, dir, h));
    unsigned* base = (unsigned*)(p.RS + (size_t)ch * NCHUNK * 4096) + e2;
    float s0 = 0.f, s1 = 0.f;
#pragma unroll 1
    for (int g = 0; g < NCHUNK / 11; ++g) {
        unsigned v[11];
#pragma unroll
        for (int s = 0; s < 11; ++s) v[s] = base[(size_t)chunk_of(dir, g * 11 + s) * 2048];
#pragma unroll
        for (int s = 0; s < 11; ++s) {
            base[(size_t)chunk_of(dir, g * 11 + s) * 2048] = pack2(s0, s1);
            s0 = gc * s0 + __uint_as_float(v[s] << 16); s1 = gc * s1 + __uint_as_float(v[s] & 0xffff0000u);
        }
    }
}

DI void retout_unit(const Params& p, int l, int b, int h, int c, LAS char* smem) {
    LAS char* sK = smem;
    LAS bf16_t* VT = (LAS bf16_t*)(smem + 128 * 144);
    const int t = tidx(), lane = t & 63, w = t >> 6, r = lane & 31, h2 = lane >> 5;
    const size_t tok0 = (size_t)b * SU + c * 128;
    const float lgf = ret_lg2(p, l, 0, h), lgb = ret_lg2(p, l, 1, h);
    __syncthreads();
    { const int j = t >> 1, half = t & 1;
      const bf16_t* kr = p.P + (tok0 + j) * PW + 256 + h * 64 + half * 32; const bf16_t* vr = kr + 256;
#pragma unroll
      for (int q4 = 0; q4 < 4; ++q4) { const bf16x8 kk = *(const bf16x8*)(kr + q4 * 8), vv = *(const bf16x8*)(vr + q4 * 8);
          *(LAS bf16x8*)(sK + j * 144 + (half * 32 + q4 * 8) * 2) = kk;
#pragma unroll
          for (int e = 0; e < 8; ++e) VT[(half * 32 + q4 * 8 + e) * IMG + j] = (bf16_t)vv[e]; } }
    const int i = 32 * w + r;
    const size_t tok = tok0 + i;
    bf16x8 Qf[4];
    { const bf16_t* qrow = p.P + tok * PW + h * 64 + 8 * h2;
#pragma unroll
      for (int st = 0; st < 4; ++st) Qf[st] = *(const bf16x8*)(qrow + 16 * st); }
    __syncthreads();
    f32x16 O0 = zero16(), O1 = zero16();
#pragma unroll
    for (int jb = 0; jb < 4; ++jb) {
        f32x16 S = zero16();
#pragma unroll
        for (int st = 0; st < 4; ++st) { const bf16x8 kf = *(const LAS bf16x8*)(sK + (jb * 32 + r) * 144 + st * 32 + h2 * 16); S = MFMA32(kf, Qf[st], S); }
#pragma unroll
        for (int q = 0; q < 16; ++q) { const int j = jb * 32 + crow(q, h2); const float e = (j <= i) ? (float)(i - j) * lgf : (float)(j - i) * lgb; S[q] *= __builtin_amdgcn_exp2f(e); }
#pragma unroll
        for (int s2 = 0; s2 < 2; ++s2) {
            const bf16x8 pb = pack8(S, s2); const int ko = jb * 32 + 16 * s2 + 4 * h2;
            O0 = MFMA32(cat4(*(const LAS s16x4*)(VT + r * IMG + ko), *(const LAS s16x4*)(VT + r * IMG + ko + 8)), pb, O0);
            O1 = MFMA32(cat4(*(const LAS s16x4*)(VT + (32 + r) * IMG + ko), *(const LAS s16x4*)(VT + (32 + r) * IMG + ko + 8)), pb, O1);
        }
    }
    {
        const bf16_t* Sf = p.RS + st_slot(b, h, 0, c) + 8 * h2; const bf16_t* Sb = p.RS + st_slot(b, h, 1, c) + 8 * h2;
        f32x16 T0 = zero16(), T1 = zero16(), U0 = zero16(), U1 = zero16();
#pragma unroll
        for (int st = 0; st < 4; ++st) {
            T0 = MFMA32(*(const bf16x8*)(Sf + r * 64 + 16 * st), Qf[st], T0); T1 = MFMA32(*(const bf16x8*)(Sf + (32 + r) * 64 + 16 * st), Qf[st], T1);
            U0 = MFMA32(*(const bf16x8*)(Sb + r * 64 + 16 * st), Qf[st], U0); U1 = MFMA32(*(const bf16x8*)(Sb + (32 + r) * 64 + 16 * st), Qf[st], U1);
        }
        const float df = exp2f((float)(i + 1) * lgf), db = exp2f((float)(128 - i) * lgb);
#pragma unroll
        for (int q = 0; q < 16; ++q) { O0[q] += df * T0[q] + db * U0[q]; O1[q] += df * T1[q] + db * U1[q]; }
    }
    float sm = 0.f;
#pragma unroll
    for (int q = 0; q < 16; ++q) sm += O0[q] + O1[q];
    sm += __shfl_xor(sm, 32, 64); const float mean = sm * (1.f / 64.f);
    float vs = 0.f;
#pragma unroll
    for (int q = 0; q < 16; ++q) { const float d0 = O0[q] - mean, d1 = O1[q] - mean; vs += d0 * d0 + d1 * d1; }
    vs += __shfl_xor(vs, 32, 64); const float rstd = rsqrtf(vs * (1.f / 64.f) + EPS);
    const bf16_t* gr = p.P + tok * PW + 768 + h * 64 + 4 * h2; bf16_t* y = p.Y + tok * DM + h * 64 + 4 * h2;
#pragma unroll
    for (int g = 0; g < 4; ++g) {
        const f32x4 g0 = ld_bf4(gr + 8 * g), g1 = ld_bf4(gr + 32 + 8 * g); f32x4 o0, o1;
#pragma unroll
        for (int j = 0; j < 4; ++j) { o0[j] = (O0[4 * g + j] - mean) * rstd * siluf(g0[j]); o1[j] = (O1[4 * g + j] - mean) * rstd * siluf(g1[j]); }
        store_bf4(y + 8 * g, o0); store_bf4(y + 32 + 8 * g, o1);
    }
}

DI bf16_t* qeol(const Params& p, int l) { return l == 0 ? (bf16_t*)p.out : p.H; }
DI void dnloc_unit(const Params& p, int l, int b, int h, int dir, int c, LAS char* smem) {
    LAS bf16_t* KT = (LAS bf16_t*)smem;
    LAS bf16_t* VT = KT + 64 * IMG;
    LAS bf16_t* LD = VT + 64 * IMG;
    LAS bf16_t* DI_ = LD;
    LAS float* fG = (LAS float*)(LD + 4 * 32 * 40);
    LAS float* fB = fG + 128;
    LAS float* fCW = fB + 128;
    LAS float* fDL = fCW + 128;
    LAS float* fTot = fDL + 128;
    LAS char* sKr = (LAS char*)(fTot + 4);
    const int t = tidx(), lane = t & 63, w = t >> 6, r = lane & 31, h2 = lane >> 5;
    const size_t tok0 = (size_t)b * SU + c * 128;
    auto tokof = [&](int a) { return tok0 + (dir ? 127 - a : a); };
    __syncthreads();
    float Gv = 0.f, bv = 0.f;
    if (t < 128) { const size_t tk = tokof(t); Gv = p.DG[tk * 8 + dir * 4 + h]; bv = p.DB[tk * 8 + dir * 4 + h];
#pragma unroll
        for (int off = 1; off < 64; off <<= 1) { const float n = __shfl_up(Gv, off, 64); if (lane >= off) Gv += n; }
        if (t == 63) fTot[0] = Gv; }
    { const int a = t >> 1, half = t & 1; const bf16_t* row = p.DNQKV + tokof(a) * 768 + h * 64 + half * 32;
#pragma unroll
      for (int q4 = 0; q4 < 4; ++q4) { const bf16x8 kk = *(const bf16x8*)(row + 256 + q4 * 8), vv = *(const bf16x8*)(row + 512 + q4 * 8);
          *(LAS bf16x8*)(sKr + a * 144 + (half * 32 + q4 * 8) * 2) = kk;
#pragma unroll
          for (int e = 0; e < 8; ++e) { const int d = half * 32 + q4 * 8 + e; KT[d * IMG + a] = (bf16_t)kk[e]; VT[d * IMG + a] = (bf16_t)vv[e]; } } }
    auto Kf = [&](int bl, int st) { return *(const LAS bf16x8*)(sKr + (bl * 32 + r) * 144 + st * 32 + h2 * 16); };
    __syncthreads();
    if (t >= 64 && t < 128) Gv += fTot[0];
    if (t < 128) { fG[t] = Gv; fB[t] = bv; }
    __syncthreads();
    const float Glast = fG[127];
    if (t < 128) { fCW[t] = bv * __expf(Gv); fDL[t] = __expf(Glast - Gv); }
    {
        f32x16 D = zero16();
#pragma unroll
        for (int st = 0; st < 4; ++st) { const bf16x8 kf = Kf(w, st); D = MFMA32(kf, kf, D); }
        const float Ga = fG[32 * w + r], ba = fB[32 * w + r];
#pragma unroll
        for (int g = 0; g < 4; ++g) { const f32x4 Gp = *(const LAS f32x4*)(fG + 32 * w + 8 * g + 4 * h2); f32x4 o;
#pragma unroll
            for (int j = 0; j < 4; ++j) { const int ap = 8 * g + 4 * h2 + j; o[j] = (ap < r) ? ba * __expf(fminf(Ga - Gp[j], 0.f)) * D[4 * g + j] : 0.f; }
            u32x2 pk; pk[0] = pack2(o[0], o[1]); pk[1] = pack2(o[2], o[3]); *(LAS u32x2*)(LD + (w * 32 + r) * 40 + 8 * g + 4 * h2) = pk; }
    }
    __syncthreads();
    if (t < 128) {
        const int I = t >> 5, cc = t & 31; const LAS bf16_t* Lb = LD + I * 32 * 40;
        float x[32];
#pragma unroll
        for (int i = 0; i < 32; ++i) {
            float a = (i == cc) ? 1.f : 0.f;
#pragma unroll
            for (int jc = 0; jc * 4 < i; ++jc) { const u32x2 raw = *(const LAS u32x2*)(Lb + i * 40 + jc * 4);
                const float l0 = __uint_as_float(raw[0] << 16), l1 = __uint_as_float(raw[0] & 0xffff0000u), l2 = __uint_as_float(raw[1] << 16), l3 = __uint_as_float(raw[1] & 0xffff0000u);
                if (jc * 4 + 0 < i) a -= l0 * x[jc * 4 + 0];
                if (jc * 4 + 1 < i) a -= l1 * x[jc * 4 + 1];
                if (jc * 4 + 2 < i) a -= l2 * x[jc * 4 + 2];
                if (jc * 4 + 3 < i) a -= l3 * x[jc * 4 + 3]; }
            x[i] = a;
            DI_[(I * 32 + i) * 40 + cc] = f2bf(a);
        }
    }
    __syncthreads();
    const bool isW = w >= 2; const int cbase = (w & 1) * 32, col = cbase + r;
    const LAS bf16_t* IMGX = isW ? KT : VT; const LAS float* coef = isW ? fCW : fB;
    bf16x8 PX[4][2];
    f32x16 MN0 = zero16(), MN1 = zero16();
#pragma unroll
    for (int I = 0; I < 4; ++I) {
        f32x16 acc;
#pragma unroll
        for (int g = 0; g < 4; ++g) { const int a0 = 32 * I + 8 * g + 4 * h2; const s16x4 im = *(const LAS s16x4*)(IMGX + col * IMG + a0); const f32x4 cf = *(const LAS f32x4*)(coef + a0);
#pragma unroll
            for (int j = 0; j < 4; ++j) acc[4 * g + j] = bf2f((bf16_t)im[j]) * cf[j]; }
        const float Ga = fG[32 * I + r], ba = fB[32 * I + r];
#pragma unroll
        for (int J = 0; J < I; ++J) {
            f32x16 Lt = zero16();
#pragma unroll
            for (int st = 0; st < 4; ++st) Lt = MFMA32(Kf(J, st), Kf(I, st), Lt);
#pragma unroll
            for (int g = 0; g < 4; ++g) { const f32x4 Gp = *(const LAS f32x4*)(fG + 32 * J + 8 * g + 4 * h2);
#pragma unroll
                for (int j = 0; j < 4; ++j) Lt[4 * g + j] *= -ba * __expf(fminf(Ga - Gp[j], 0.f)); }
            acc = MFMA32(pack8(Lt, 0), PX[J][0], acc); acc = MFMA32(pack8(Lt, 1), PX[J][1], acc);
        }
        f32x16 X = zero16();
#pragma unroll
        for (int s2 = 0; s2 < 2; ++s2) { const LAS bf16_t* dr = DI_ + (I * 32 + r) * 40 + 16 * s2 + 4 * h2;
            X = MFMA32(cat4(*(const LAS s16x4*)dr, *(const LAS s16x4*)(dr + 8)), pack8(acc, s2), X); }
        PX[I][0] = pack8(X, 0); PX[I][1] = pack8(X, 1);
#pragma unroll
        for (int g = 0; g < 4; ++g) { const f32x4 dl = *(const LAS f32x4*)(fDL + 32 * I + 8 * g + 4 * h2);
#pragma unroll
            for (int j = 0; j < 4; ++j) X[4 * g + j] *= dl[j]; }
#pragma unroll
        for (int s2 = 0; s2 < 2; ++s2) { const bf16x8 px = pack8(X, s2); const int ka = 32 * I + 16 * s2 + 4 * h2;
            const bf16x8 kt0 = cat4(*(const LAS s16x4*)(KT + r * IMG + ka), *(const LAS s16x4*)(KT + r * IMG + ka + 8));
            const bf16x8 kt1 = cat4(*(const LAS s16x4*)(KT + (32 + r) * IMG + ka), *(const LAS s16x4*)(KT + (32 + r) * IMG + ka + 8));
            if (isW) { MN0 = MFMA32(px, kt0, MN0); MN1 = MFMA32(px, kt1, MN1); } else { MN0 = MFMA32(kt0, px, MN0); MN1 = MFMA32(kt1, px, MN1); } }
    }
    {
        const size_t slot = st_slot(b, h, dir, c);
        if (isW) {
            const float eg = __expf(Glast);
#pragma unroll
            for (int g = 0; g < 4; ++g) { f32x4 m0, m1;
#pragma unroll
                for (int j = 0; j < 4; ++j) { const int dp = cbase + 8 * g + 4 * h2 + j; m0[j] = (dp == r ? eg : 0.f) - MN0[4 * g + j]; m1[j] = (dp == 32 + r ? eg : 0.f) - MN1[4 * g + j]; }
                store_bf4(p.DNM + slot + r * 64 + cbase + 8 * g + 4 * h2, m0); store_bf4(p.DNM + slot + (32 + r) * 64 + cbase + 8 * g + 4 * h2, m1); }
        } else {
#pragma unroll
            for (int g = 0; g < 4; ++g) { store_bf4(p.DNN + slot + col * 64 + 8 * g + 4 * h2, (f32x4){MN0[4 * g], MN0[4 * g + 1], MN0[4 * g + 2], MN0[4 * g + 3]});
                store_bf4(p.DNN + slot + col * 64 + 32 + 8 * g + 4 * h2, (f32x4){MN1[4 * g], MN1[4 * g + 1], MN1[4 * g + 2], MN1[4 * g + 3]}); }
        }
    }
    bf16_t* QE = qeol(p, l) + (size_t)dir * NT * 256; bf16_t* OL = qeol(p, l) + (size_t)(2 + dir) * NT * 256;
    LAS char* sQ = (LAS char*)VT;
    __syncthreads();
    { const int a = t >> 1, half = t & 1; const bf16_t* row = p.DNQKV + tokof(a) * 768 + h * 64 + half * 32;
#pragma unroll
      for (int q4 = 0; q4 < 4; ++q4) *(LAS bf16x8*)(sQ + a * 144 + (half * 32 + q4 * 8) * 2) = *(const bf16x8*)(row + q4 * 8); }
    __syncthreads();
#pragma unroll
    for (int I = 0; I < 4; ++I) {
        const size_t tk = tokof(32 * I + r);
        bf16x8 Qf[4];
#pragma unroll
        for (int st = 0; st < 4; ++st) Qf[st] = *(const LAS bf16x8*)(sQ + (32 * I + r) * 144 + st * 32 + h2 * 16);
        const float Ga = fG[32 * I + r];
        f32x16 out = zero16();
#pragma unroll
        for (int J = 0; J <= I; ++J) {
            f32x16 At = zero16();
#pragma unroll
            for (int st = 0; st < 4; ++st) At = MFMA32(Kf(J, st), Qf[st], At);
#pragma unroll
            for (int g = 0; g < 4; ++g) { const f32x4 Gp = *(const LAS f32x4*)(fG + 32 * J + 8 * g + 4 * h2);
#pragma unroll
                for (int j = 0; j < 4; ++j) { const int ap = 8 * g + 4 * h2 + j; const float e = __expf(fminf(Ga - Gp[j], 0.f)); At[4 * g + j] = (J < I || ap <= r) ? e * At[4 * g + j] : 0.f; } }
            out = MFMA32(PX[J][0], pack8(At, 0), out); out = MFMA32(PX[J][1], pack8(At, 1), out);
        }
        if (!isW) {
#pragma unroll
            for (int g = 0; g < 4; ++g) store_bf4(OL + tk * 256 + h * 64 + cbase + 8 * g + 4 * h2, (f32x4){out[4 * g], out[4 * g + 1], out[4 * g + 2], out[4 * g + 3]});
        } else {
            const float ega = __expf(Ga);
#pragma unroll
            for (int g = 0; g < 4; ++g) { const u32x2 raw = *(const LAS u32x2*)(sQ + (32 * I + r) * 144 + (cbase + 8 * g + 4 * h2) * 2);
                f32x4 qv; qv[0] = __uint_as_float(raw[0] << 16); qv[1] = __uint_as_float(raw[0] & 0xffff0000u); qv[2] = __uint_as_float(raw[1] << 16); qv[3] = __uint_as_float(raw[1] & 0xffff0000u);
                f32x4 o;
#pragma unroll
                for (int j = 0; j < 4; ++j) o[j] = ega * qv[j] - out[4 * g + j];
                store_bf4(QE + tk * 256 + h * 64 + cbase + 8 * g + 4 * h2, o); }
        }
    }
}

DI void dn_scan(const Params& p, int ch, LAS char* smem) {
    const int t = tidx(), lane = t & 63, vg = t >> 6, fr = lane & 15, fq = lane >> 4, dir = ch & 1;
    const size_t cbase = (size_t)ch * NCHUNK * 4096;
    f32x4 acc[4];
#pragma unroll
    for (int mt = 0; mt < 4; ++mt) acc[mt] = (f32x4){0.f, 0.f, 0.f, 0.f};
    constexpr int D = 8;
    u32x4 mq[D][2]; u32x2 nq[D][4];
    const int mrow = lane >> 3, mch = lane & 7;
    auto issue = [&](int step, u32x4 (&m)[2], u32x2 (&n)[4]) {
        const size_t so = cbase + (size_t)chunk_of(dir, step) * 4096;
        const bf16_t* M = p.DNM + so + (size_t)(16 * vg + mrow) * 64 + mch * 8; const bf16_t* N = p.DNN + so + (vg * 16 + fr) * 64 + 4 * fq;
        m[0] = *(const u32x4*)M; m[1] = *(const u32x4*)(M + 8 * 64);
#pragma unroll
        for (int mt = 0; mt < 4; ++mt) n[mt] = *(const u32x2*)(N + 16 * mt);
    };
#pragma unroll
    for (int j = 0; j < D; ++j) issue(j, mq[j], nq[j]);
    __syncthreads();
    for (int base = 0; base < NCHUNK; base += D) {
#pragma unroll
        for (int j = 0; j < D; ++j) {
            const int step = base + j;
            if (step < NCHUNK) {
                LAS char* slot = smem + (step & 1) * 8192;
                {
                    const int r0 = 16 * vg + mrow, r1 = r0 + 8;
                    *(LAS u32x4*)(slot + r0 * 128 + ((mch ^ (r0 & 7)) * 16)) = mq[j][0];
                    *(LAS u32x4*)(slot + r1 * 128 + ((mch ^ (r1 & 7)) * 16)) = mq[j][1];
                }
                f32x4 n4[4];
#pragma unroll
                for (int mt = 0; mt < 4; ++mt) { n4[mt][0] = __uint_as_float(nq[j][mt][0] << 16); n4[mt][1] = __uint_as_float(nq[j][mt][0] & 0xffff0000u); n4[mt][2] = __uint_as_float(nq[j][mt][1] << 16); n4[mt][3] = __uint_as_float(nq[j][mt][1] & 0xffff0000u); }
                bf16_t* sp = p.DSP + cbase + (size_t)chunk_of(dir, step) * 4096 + (vg * 16 + fr) * 64 + 4 * fq;
#pragma unroll
                for (int mt = 0; mt < 4; ++mt) store_bf4(sp + 16 * mt, acc[mt]);
                if (step + D < NCHUNK) issue(step + D, mq[j], nq[j]);
                u32x4 b0, b1;
                b0[0] = pack2(acc[0][0], acc[0][1]); b0[1] = pack2(acc[0][2], acc[0][3]); b0[2] = pack2(acc[1][0], acc[1][1]); b0[3] = pack2(acc[1][2], acc[1][3]);
                b1[0] = pack2(acc[2][0], acc[2][1]); b1[1] = pack2(acc[2][2], acc[2][3]); b1[2] = pack2(acc[3][0], acc[3][1]); b1[3] = pack2(acc[3][2], acc[3][3]);
                const bf16x8 B0 = __builtin_bit_cast(bf16x8, b0), B1 = __builtin_bit_cast(bf16x8, b1);
                __syncthreads();
#pragma unroll
                for (int mt = 0; mt < 4; ++mt) {
                    const int row = 16 * mt + fr; const LAS char* rp = slot + row * 128 + (fq & 1) * 8;
                    const int c0 = (fq >> 1);
                    const bf16x8 A0 = cat4(*(const LAS s16x4*)(rp + (((c0) ^ (row & 7)) * 16)), *(const LAS s16x4*)(rp + (((c0 + 2) ^ (row & 7)) * 16)));
                    const bf16x8 A1 = cat4(*(const LAS s16x4*)(rp + (((c0 + 4) ^ (row & 7)) * 16)), *(const LAS s16x4*)(rp + (((c0 + 6) ^ (row & 7)) * 16)));
                    f32x4 a = n4[mt]; a = __builtin_amdgcn_mfma_f32_16x16x32_bf16(A0, B0, a, 0, 0, 0); a = __builtin_amdgcn_mfma_f32_16x16x32_bf16(A1, B1, a, 0, 0, 0); acc[mt] = a;
                }
            }
        }
    }
}

DI void dnout_unit(const Params& p, int l, int b, int h, int c) {
    const int t = tidx(), lane = t & 63, w = t >> 6, r = lane & 31, h2 = lane >> 5;
    const size_t tok = (size_t)b * SU + c * 128 + 32 * w + r;
    f32x16 O0, O1;
    {
        const bf16_t* o0 = qeol(p, l) + (size_t)2 * NT * 256 + tok * 256 + h * 64 + 4 * h2; const bf16_t* o1 = o0 + (size_t)NT * 256;
#pragma unroll
        for (int g = 0; g < 4; ++g) { const f32x4 a = ld_bf4(o0 + 8 * g) + ld_bf4(o1 + 8 * g), bq = ld_bf4(o0 + 32 + 8 * g) + ld_bf4(o1 + 32 + 8 * g);
#pragma unroll
            for (int j = 0; j < 4; ++j) { O0[4 * g + j] = a[j]; O1[4 * g + j] = bq[j]; } }
    }
#pragma unroll
    for (int dir = 0; dir < 2; ++dir) {
        const bf16_t* qe = qeol(p, l) + (size_t)dir * NT * 256 + tok * 256 + h * 64 + 8 * h2;
        const bf16_t* sT = p.DSP + st_slot(b, h, dir, c) + 8 * h2;
#pragma unroll
        for (int st = 0; st < 4; ++st) { const bf16x8 qf = *(const bf16x8*)(qe + 16 * st);
            O0 = MFMA32(*(const bf16x8*)(sT + r * 64 + 16 * st), qf, O0); O1 = MFMA32(*(const bf16x8*)(sT + (32 + r) * 64 + 16 * st), qf, O1); }
    }
    float ss = 0.f;
#pragma unroll
    for (int q = 0; q < 16; ++q) ss += O0[q] * O0[q] + O1[q] * O1[q];
    ss += __shfl_xor(ss, 32, 64); const float rstd = rsqrtf(ss * (1.f / 64.f) + EPS);
    const bf16_t* zr = p.P + tok * PW + OFF_DNZ + h * 64 + 4 * h2; bf16_t* y = p.Y + tok * DM + 512 + h * 64 + 4 * h2;
    const float* ng = p.dn_norm_g + l * 64 + 4 * h2;
#pragma unroll
    for (int g = 0; g < 4; ++g) {
        const f32x4 z0 = ld_bf4(zr + 8 * g), z1 = ld_bf4(zr + 32 + 8 * g), n0 = *(const f32x4*)(ng + 8 * g), n1 = *(const f32x4*)(ng + 32 + 8 * g); f32x4 o0, o1;
#pragma unroll
        for (int j = 0; j < 4; ++j) { o0[j] = O0[4 * g + j] * rstd * n0[j] * siluf(z0[j]); o1[j] = O1[4 * g + j] * rstd * n1[j] * siluf(z1[j]); }
        store_bf4(y + 8 * g, o0); store_bf4(y + 32 + 8 * g, o1);
    }
}

DI void ph_local(const Params& p, int l, LAS char* smem) {
    const int nd = DN_NEW ? 2 * 16 * NCHUNK : 0, nr = RET_NEW ? 16 * NCHUNK : 0, nm = NMT * 3;
    for (int u = bidx(); u < nd + nr + nm; u += gdim()) {
        if (u < nd) { const int c = u % NCHUNK, ch = u / NCHUNK; for (int rep = 0; rep < REP_DNL; ++rep) dnloc_unit(p, l, ch >> 3, (ch >> 1) & 3, ch & 1, c, smem); }
        else if (u < nd + nr) { const int v = u - nd, c = v % NCHUNK, bh = v / NCHUNK; for (int rep = 0; rep < REP_RKV; ++rep) retkv_unit(p, l, bh >> 2, bh & 3, c, smem); }
        else for (int rep = 0; rep < REP_MLA; ++rep) { const int v = u - nd - nr; ph_mla_up_unit(p, (v / 3) * 7 + v % 3, smem); }
    }
}
DI void ph_scan2(const Params& p, int l, LAS char* smem) {
    const int bid = bidx();
    if (bid >= 16 && bid < 48) { if (DN_NEW) for (int rep = 0; rep < REP_DNSCAN; ++rep) dn_scan(p, bid - 16, smem); }
    else {
        const int pi = bid < 16 ? bid : bid - 32, ps = gdim() - 32;
        if (RET_NEW) { for (int gid = pi * NTHR + tidx(); gid < 65536; gid += ps * NTHR) ret_scan(p, l, gid); }
        for (int v = pi; v < NB * NCHUNK * 4; v += ps) { const int g = v & 3, bc = v >> 2, b = bc / NCHUNK, c = bc % NCHUNK; if (l == 0 || c >= 2) sgm_unit(p, l, b, c, g, smem); }
        for (int u = pi; u < NMT * 4; u += ps) for (int rep = 0; rep < REP_MLA; ++rep) ph_mla_up_unit(p, (u >> 2) * 7 + 3 + (u & 3), smem);
    }
}
DI void ph_output(const Params& p, int l, LAS char* smem) {
    {
        const int x = bidx() & 7, lb = bidx() >> 3, gl = gdim() >> 3;
        LAS int* badl = (LAS int*)(smem + 49152 + 16);
        int nbad = 0;
        for (int rep = 0; rep < REP_ATT; ++rep) for (int j = lb; j < 64; j += gl) { const int bh = x + 8 * (j >> 5), qb = j & 31;
            if (attn_unit(p, bh >> 2, bh & 3, CTXL + qb * 256, SU, smem)) { if (tidx() == 0) badl[nbad] = j; ++nbad; } }
        if (nbad) {
            __syncthreads();
            for (int k = 0; k < nbad; ++k) { const int j = __builtin_amdgcn_readfirstlane(badl[k]); const int bh = x + 8 * (j >> 5), qb = j & 31; attn_unit_classic(p, bh >> 2, bh & 3, CTXL + qb * 256, SU, smem); }
        }
    }
    const int natt = (l == 0 ? 16 : 0);
    const int nro = RET_NEW ? 16 * NCHUNK : 0, ndo = DN_NEW ? 16 * NCHUNK : 0, nsg = 0;
    for (int u = bidx(); u < natt + nro + ndo + nsg; u += gdim()) {
        if (u < natt) { const int bh = u; attn_unit_classic(p, bh >> 2, bh & 3, 0, CTXL, smem); }
        else if (u < natt + nro) { const int v = u - natt, c = v % NCHUNK, bh = v / NCHUNK; if (l == 0 || c >= 2) for (int rep = 0; rep < REP_RO; ++rep) retout_unit(p, l, bh >> 2, bh & 3, c, smem); }
        else if (u < natt + nro + ndo) { const int v = u - natt - nro, c = v % NCHUNK, bh = v / NCHUNK; if (l == 0 || c >= 2) for (int rep = 0; rep < REP_DO; ++rep) dnout_unit(p, l, bh >> 2, bh & 3, c); }
        else { const int v = u - natt - nro - ndo, g = v & 3, bc = v >> 2, b = bc / NCHUNK, c = bc % NCHUNK; if (l == 0 || c >= 2) for (int rep = 0; rep < REP_SG; ++rep) sgm_unit(p, l, b, c, g, smem); }
    }
}

DI bool mt_active(int l, int mt) { return l == 0 || (mt % NCHUNK) >= 2; }
template <int NF>
DI void merge_unit(const Params& p, int mt, int nt, LAS char* smem) {
    bf16_t* ACC = p.P;
    const int t = tidx(), lane = t & 63, wave = t >> 6, wr = wave >> 1, wc = wave & 1, fr = lane & 15, fq = lane >> 4;
    const int lrow = lane >> 3, lch = (lane & 7) ^ lrow;
    unsigned ao[4], boB[NF], boG[NF];
#pragma unroll
    for (int i = 0; i < 4; ++i) ao[i] = (unsigned)((((wave + 4 * i) * 8 + lrow) * DM + lch * 8) * 2);
#pragma unroll
    for (int i = 0; i < NF; ++i) { const int br = brow_src((wave + 4 * i) * 8 + lrow); boB[i] = (unsigned)((br * 256 + lch * 8) * 2); boG[i] = (unsigned)((br * DM + lch * 8) * 2); }
    const unsigned ldsw = (unsigned)__builtin_amdgcn_readfirstlane((int)((unsigned)(size_t)smem + wave * 1024));
    const bf16_t* Ah = p.H + (size_t)mt * 128 * DM; const bf16_t* Ay = p.Y + (size_t)mt * 128 * DM;
    auto Aof = [&](int s_) { return (s_ & 1) ? Ah : Ay + (s_ >> 1) * 256; };
    auto Bof = [&](int s_) { const int i = s_ >> 1; return (s_ & 1) ? p.WinT + ((size_t)OFF_GATE + i * DM + nt * 32 * NF) * DM : p.WbrT + ((size_t)i * DM + nt * 32 * NF) * 256; };
    auto stage = [&](int s_, int buf, int k0) {
        const bf16_t* A = Aof(s_) + k0; const bf16_t* B = Bof(s_) + k0; const unsigned dA = ldsw + buf * 32768, dB = dA + 16384;
#pragma unroll
        for (int i = 0; i < 4; ++i) glds16(A, ao[i], dA + i * 4096);
        if (s_ & 1) {
#pragma unroll
            for (int i = 0; i < NF; ++i) glds16(B, boG[i], dB + i * 4096);
        } else {
#pragma unroll
            for (int i = 0; i < NF; ++i) glds16(B, boB[i], dB + i * 4096);
        }
    };
    const int sw = (fq ^ (fr & 7)) * 16;
    const int aoff0 = (wr * 64 + fr) * 128 + sw, boff0 = (wc * 16 * NF + fr) * 128 + sw + 16384;
    auto run = [&](f32x4 (&acc)[4][NF], int s_) {
        const int nk = (s_ & 1) ? 16 : 4;
        __syncthreads();
        asm volatile("s_waitcnt vmcnt(0)" ::: "memory");
        __syncthreads();
        stage(s_, 1, 64);
        for (int kt = 0; kt < nk; ++kt) {
            const LAS char* sA = smem + (kt & 1) * 32768;
#pragma unroll
            for (int kk = 0; kk < 2; ++kk) {
                bf16x8 af[4], bf[NF];
                const LAS char* pa = sA + (kk ? (aoff0 ^ 64) : aoff0); const LAS char* pb_ = sA + (kk ? (boff0 ^ 64) : boff0);
#pragma unroll
                for (int m = 0; m < 4; ++m) af[m] = *(const LAS bf16x8*)(pa + m * 2048);
#pragma unroll
                for (int n = 0; n < NF; ++n) bf[n] = *(const LAS bf16x8*)(pb_ + n * 2048);
#pragma unroll
                for (int m = 0; m < 4; ++m)
#pragma unroll
                    for (int n = 0; n < NF; ++n) acc[m][n] = __builtin_amdgcn_mfma_f32_16x16x32_bf16(bf[n], af[m], acc[m][n], 0, 0, 0);
            }
            asm volatile("s_waitcnt vmcnt(0)" ::: "memory");
            __syncthreads();
            if (kt + 2 < nk) stage(s_, kt & 1, (kt + 2) * 64);
            else if (kt + 2 == nk && s_ < 7) stage(s_ + 1, 0, 0);
        }
    };
    unsigned outp[4][NF][2];
#pragma unroll
    for (int m = 0; m < 4; ++m)
#pragma unroll
        for (int n = 0; n < NF; ++n) { outp[m][n][0] = 0u; outp[m][n][1] = 0u; }
    __syncthreads();
    stage(0, 0, 0);
#pragma unroll 1
    for (int i = 0; i < 4; ++i) {
        unsigned pb[4][NF][2];
        { f32x4 accB[4][NF]; zero_acc(accB);
          run(accB, 2 * i);
#pragma unroll
          for (int m = 0; m < 4; ++m)
#pragma unroll
              for (int n = 0; n < NF; ++n) { pb[m][n][0] = pack2(accB[m][n][0], accB[m][n][1]); pb[m][n][1] = pack2(accB[m][n][2], accB[m][n][3]); } }
        f32x4 accG[4][NF]; zero_acc(accG);
        run(accG, 2 * i + 1);
#pragma unroll
        for (int m = 0; m < 4; ++m)
#pragma unroll
            for (int n = 0; n < NF; ++n) {
                const float o0 = __uint_as_float(outp[m][n][0] << 16) + sig2(accG[m][n][0]) * __uint_as_float(pb[m][n][0] << 16);
                const float o1 = __uint_as_float(outp[m][n][0] & 0xffff0000u) + sig2(accG[m][n][1]) * __uint_as_float(pb[m][n][0] & 0xffff0000u);
                const float o2 = __uint_as_float(outp[m][n][1] << 16) + sig2(accG[m][n][2]) * __uint_as_float(pb[m][n][1] << 16);
                const float o3 = __uint_as_float(outp[m][n][1] & 0xffff0000u) + sig2(accG[m][n][3]) * __uint_as_float(pb[m][n][1] & 0xffff0000u);
                outp[m][n][0] = pack2(o0, o1); outp[m][n][1] = pack2(o2, o3);
            }
    }
    bf16_t* o = ACC + (size_t)mt * 128 * DM + nt * 32 * NF;
#pragma unroll
    for (int m = 0; m < 4; ++m)
#pragma unroll
        for (int k = 0; k < NF / 2; ++k) { u32x4 v; v[0] = outp[m][2 * k][0]; v[1] = outp[m][2 * k][1]; v[2] = outp[m][2 * k + 1][0]; v[3] = outp[m][2 * k + 1][1];
            *(u32x4*)(o + (size_t)(wr * 64 + m * 16 + fr) * DM + wc * 16 * NF + k * 32 + fq * 8) = v; }
}
DI void ph_merge(const Params& p, int l, LAS char* smem) {
    const TileDeal dl = deal_init(256, 8);
    for (int j = dl.lb; j < dl.total; j += dl.gl) { int mt, nt; deal_map(dl, j, mt, nt); merge_unit<4>(p, mt, nt, smem); }
    if (l == 0) for (int u = bidx(); u < 8 * 16; u += gdim()) merge_unit<2>(p, ctx_mt(u >> 4), u & 15, smem);
}

template <int NF, class NextF = NoNext>
DI void wout_unit(const Params& p, int mt, int nt, LAS char* smem, bool pre = false, NextF next = NextF()) {
    f32x4 acc[4][NF]; zero_acc(acc);
    const bf16_t* A = p.P + (size_t)mt * 128 * DM;
    gemm_tile(acc, A, [&](int r) { return r * DM; }, p.WoutT + (size_t)nt * 32 * NF * DM, DM, DM, smem, pre, next);
    bf16_t* o = p.H + (size_t)mt * 128 * DM + nt * 32 * NF;
    for_frags(acc, [&](int r, int c, f32x4 lo, f32x4 hi) { store_bf8(o + (size_t)r * DM + c, lo, hi); });
}
DI void ph_wout(const Params& p, int l, LAS char* smem) {
    const TileDeal dl = deal_init(256, 8);
    bool pre = false;
    for (int j = dl.lb; j < dl.total; j += dl.gl) { int mt, nt; deal_map(dl, j, mt, nt);
        const int jn = j + dl.gl; const bool hasn = jn < dl.total; int mtn = 0, ntn = 0; if (hasn) deal_map(dl, jn, mtn, ntn);
        wout_unit<4>(p, mt, nt, smem, pre, [&]() { if (hasn) gemm_prestage<4>(p.P + (size_t)mtn * 128 * DM, [&](int r) { return r * DM; }, p.WoutT + (size_t)ntn * 128 * DM, DM, smem); });
        pre = hasn; }
    if (l == 0) for (int u = bidx(); u < 8 * 16; u += gdim()) wout_unit<2>(p, ctx_mt(u >> 4), u & 15, smem);
}

DI void ph_r2(const Params& p, int l, LAS char* smem, bool dry = false) {
    LAS float* rwT = (LAS float*)smem;
    __syncthreads();
    for (int i = tidx(); i < DM * 4; i += NTHR) { const f32x4 v = *(const f32x4*)(p.router_w + (size_t)i * 4); const int d = i >> 2, e0 = (i & 3) * 4;
        rwT[(e0 + 0) * DM + d] = v[0]; rwT[(e0 + 1) * DM + d] = v[1]; rwT[(e0 + 2) * DM + d] = v[2]; rwT[(e0 + 3) * DM + d] = v[3]; }
    __syncthreads();
    LAS int* bcnt = (LAS int*)(smem + 65536); LAS int* bbase = bcnt + 16; LAS unsigned* rec = (LAS unsigned*)(bbase + 16);
    if (tidx() < 16) bcnt[tidx()] = 0;
    __syncthreads();
    const int lane = tidx() & 63, wv_ = tidx() >> 6, gw = bidx() * 4 + wv_, nw = gdim() * 4;
    int kk = -1;
    auto active = [&](int tok) { return tok < NT && !(l == 1 && tok_s(tok) < CTXL); };
    u32x2 ya[4], yb[4]; f32x4 xa[4], xb[4];
    auto load = [&](int tok, u32x2 (&yy)[4], f32x4 (&xx)[4]) {
        const float* xs = xrow_src(p, l, tok); const bf16_t* hrow = p.H + (size_t)tok * DM;
#pragma unroll
        for (int i = 0; i < 4; ++i) { yy[i] = *(const u32x2*)(hrow + lane * 4 + 256 * i); xx[i] = *(const f32x4*)(xs + lane * 4 + 256 * i); }
    };
    if (active(gw)) load(gw, ya, xa);
    for (int tok = gw; tok < NT; tok += nw) {
        ++kk;
        { const int nxt = tok + nw; if (active(nxt)) load(nxt, yb, xb); }
        if (!active(tok)) {
#pragma unroll
            for (int i = 0; i < 4; ++i) { ya[i] = yb[i]; xa[i] = xb[i]; }
            continue; }
        float* xd = dry ? (float*)p.Y + (size_t)(tok & 8191) * DM : xrow_dst(p, tok);
        bf16_t* hrow = p.H + (size_t)tok * DM; bf16_t* hout = dry ? p.Y + (size_t)8192 * DM * 2 + (size_t)(tok & 8191) * DM : hrow;
        const float* g1 = mod_row(p, l, tok, 2); const float* sh2 = mod_row(p, l, tok, 3); const float* sc2 = mod_row(p, l, tok, 4);
        f32x4 y[4]; float ss = 0.f;
#pragma unroll
        for (int i = 0; i < 4; ++i) { const u32x2 raw = ya[i];
            y[i][0] = __uint_as_float(raw[0] << 16); y[i][1] = __uint_as_float(raw[0] & 0xffff0000u); y[i][2] = __uint_as_float(raw[1] << 16); y[i][3] = __uint_as_float(raw[1] & 0xffff0000u);
            ss += y[i][0] * y[i][0] + y[i][1] * y[i][1] + y[i][2] * y[i][2] + y[i][3] * y[i][3]; }
        ss = wave_sum(ss); const float rstd = rsqrtf(ss * (1.f / DM) + EPS);
        f32x4 xn[4]; float ss2 = 0.f;
#pragma unroll
        for (int i = 0; i < 4; ++i) { const int d = lane * 4 + 256 * i; const f32x4 xv = xa[i], gp = *(const f32x4*)(p.g_post1 + (size_t)l * DM + d), gt = *(const f32x4*)(g1 + d);
#pragma unroll
            for (int j = 0; j < 4; ++j) { xn[i][j] = xv[j] + gt[j] * (y[i][j] * rstd * gp[j]); ss2 += xn[i][j] * xn[i][j]; }
            *(f32x4*)(xd + d) = xn[i]; }
        ss2 = wave_sum(ss2); const float rstd2 = rsqrtf(ss2 * (1.f / DM) + EPS);
        float lg[16];
#pragma unroll
        for (int e = 0; e < 16; ++e) lg[e] = 0.f;
#pragma unroll
        for (int i = 0; i < 4; ++i) { const int d = lane * 4 + 256 * i; const f32x4 gp = *(const f32x4*)(p.g_pre2 + (size_t)l * DM + d), s1 = *(const f32x4*)(sc2 + d), s0 = *(const f32x4*)(sh2 + d);
            f32x4 hv;
#pragma unroll
            for (int j = 0; j < 4; ++j) hv[j] = xn[i][j] * rstd2 * gp[j] * (1.f + s1[j]) + s0[j];
#pragma unroll
            for (int e = 0; e < 16; ++e) { const f32x4 wv = *(const LAS f32x4*)(rwT + e * DM + d); lg[e] += hv[0] * wv[0] + hv[1] * wv[1] + hv[2] * wv[2] + hv[3] * wv[3]; }
            store_bf4(hout + d, hv); }
#pragma unroll
        for (int e = 0; e < 16; ++e) lg[e] = wave_sum(lg[e]);
#pragma unroll
        for (int i = 0; i < 4; ++i) { ya[i] = yb[i]; xa[i] = xb[i]; }
        if (lane == 0 && !dry) {
            float aff[16], sel[16];
#pragma unroll
            for (int e = 0; e < 16; ++e) { aff[e] = sigmoidf_(lg[e]); sel[e] = aff[e] + p.router_bias[e]; }
            int best = 0; float bests = -1e30f;
#pragma unroll
            for (int g = 0; g < 4; ++g) { float m1 = -1e30f, m2 = -1e30f;
#pragma unroll
                for (int j = 0; j < 4; ++j) { const float v = sel[g * 4 + j]; if (v > m1) { m2 = m1; m1 = v; } else if (v > m2) m2 = v; }
                const float gs = m1 + m2; if (gs > bests) { bests = gs; best = g; } }
            int i0 = 0, i1 = 0; float m1 = -1e30f, m2 = -1e30f, a0 = 0.f, a1 = 0.f;
#pragma unroll
            for (int g = 0; g < 4; ++g)
#pragma unroll
                for (int j = 0; j < 4; ++j) if (g == best) { const float v = sel[g * 4 + j]; const float a = aff[g * 4 + j];
                    if (v > m1) { m2 = m1; i1 = i0; a1 = a0; m1 = v; i0 = g * 4 + j; a0 = a; } else if (v > m2) { m2 = v; i1 = g * 4 + j; a1 = a; } }
            const float inv = 1.f / (a0 + a1);
            p.ewt[(size_t)tok * 2] = a0 * inv; p.ewt[(size_t)tok * 2 + 1] = a1 * inv;
            const unsigned lp0 = (unsigned)__hip_atomic_fetch_add(&bcnt[i0], 1, __ATOMIC_RELAXED, __HIP_MEMORY_SCOPE_WORKGROUP);
            const unsigned lp1 = (unsigned)__hip_atomic_fetch_add(&bcnt[i1], 1, __ATOMIC_RELAXED, __HIP_MEMORY_SCOPE_WORKGROUP);
            rec[wv_ * 40 + kk] = (unsigned)i0 | (lp0 << 4) | ((unsigned)i1 << 16) | (lp1 << 20);
        }
    }
    __syncthreads();
    if (dry) return;
    if (tidx() < 16) bbase[tidx()] = atomicAdd(&p.cnt[tidx()], bcnt[tidx()]);
    __syncthreads();
    {
        const int tok = gw + lane * nw;
        if (lane < 40 && tok < NT && !(l == 1 && tok_s(tok) < CTXL)) {
            const unsigned rc = rec[wv_ * 40 + lane]; const int e0 = rc & 15, l0 = (rc >> 4) & 0xfff, e1 = (rc >> 16) & 15, l1 = rc >> 20;
            p.elist[(size_t)e0 * NT + bbase[e0] + l0] = tok * 2; p.elist[(size_t)e1 * NT + bbase[e1] + l1] = tok * 2 + 1;
        }
    }
}

DI int sh_tok(int l, int pos) { return l == 0 ? pos : (pos >> 13) * SU + CTXL + (pos & 8191); }
DI void moe_offsets(const Params& p, int l, LAS int* soff) {
    __syncthreads();
    if (tidx() == 0) { int a = 0; for (int e = 0; e < 16; ++e) { const int c = p.cnt[e]; soff[e] = a; soff[17 + e] = c; a += c; } soff[16] = 2 * NT; soff[33] = l == 0 ? NT : NB * SEQ;
        int t = 0; for (int e = 0; e < 17; ++e) { soff[34 + e] = t; t += (soff[17 + e] + 127) >> 7; } soff[51] = t; }
    __syncthreads();
}
DI void moe_tile(const LAS int* soff, int t, int& e, int& mt) { e = 0; while (e < 16 && t >= soff[35 + e]) ++e; mt = t - soff[34 + e]; }
DI void ph_moe1(const Params& p, int l, LAS char* smem) {
    LAS int* soff = (LAS int*)(smem + 65536);
    moe_offsets(p, l, soff);
    bf16_t* ACT = p.Y;
    const int T = soff[51], xg = bidx() & 7, lbx = bidx() >> 3, glx = gdim() >> 3;
    const int NQ = ((T - xg + 7) >> 3) * 4;
    for (int q = lbx; q < NQ; q += glx) {
        const int nt = q & 3; int e, mt; moe_tile(soff, (q >> 2) * 8 + xg, e, mt);
        const int cnt = soff[17 + e];
        const int* lst = p.elist + (size_t)e * NT;
        auto tokof = [&](int r) { int pos = mt * 128 + r; if (pos >= cnt) pos = mt * 128; return e < 16 ? (lst[pos] >> 1) : sh_tok(l, pos); };
        f32x4 acc[4][4]; zero_acc(acc);
        gemm_tile_g(acc, p.H, [&](int r) { return tokof(r) * DM; }, p.W1T + ((size_t)e * 256 + nt * 64) * DM,
                    [&](int rr) { const int grp = rr >> 5; return ((grp & 1) * (17 * 256) + (grp >> 1) * 32 + perm32(rr & 31)) * DM; }, DM, smem);
        bf16_t* o = ACT + ((size_t)soff[e] + mt * 128) * 256 + nt * 64;
        {
            const int t = tidx(), lane = t & 63, wave = t >> 6, wr = wave >> 1, wc = wave & 1, fr = lane & 15, fq = lane >> 4;
#pragma unroll
            for (int m = 0; m < 4; ++m) { const int r = wr * 64 + m * 16 + fr; f32x4 lo, hi;
#pragma unroll
                for (int j = 0; j < 4; ++j) { lo[j] = siluf(acc[m][0][j]) * acc[m][2][j]; hi[j] = siluf(acc[m][1][j]) * acc[m][3][j]; }
                if (mt * 128 + r < cnt) store_bf8(o + (size_t)r * 256 + wc * 32 + fq * 8, lo, hi); }
        }
    }
}
DI void ph_moe2(const Params& p, int l, LAS char* smem) {
    LAS int* soff = (LAS int*)(smem + 65536);
    moe_offsets(p, l, soff);
    const bf16_t* ACT = p.Y; bf16_t* SLOT = p.P; bf16_t* SHOUT = p.H;
    const int T = soff[51], xg = bidx() & 7, lbx = bidx() >> 3, glx = gdim() >> 3;
    const int NU = ((T - xg + 7) >> 3) * 8;
    bool pre = false; int uc = 0;
    for (int u = lbx; u < NU; ) {
        const int nt = u & 7; int e, mt; moe_tile(soff, (u >> 3) * 8 + xg, e, mt);
        const int cnt = soff[17 + e];
        const int un = u + glx; const bool hasn = un < NU;
        int en = 0, mtn = 0; if (hasn) moe_tile(soff, (un >> 3) * 8 + xg, en, mtn);
        const int cntn = hasn ? soff[17 + en] : 0;
        const bf16_t* A = ACT + ((size_t)soff[e] + mt * 128) * 256;
        const bf16_t* An = ACT + ((size_t)soff[en] + mtn * 128) * 256;
        const bf16_t* Bn = p.W2T + ((size_t)en * DM + (un & 7) * 128) * 256;
        LAS int* rowpair = (LAS int*)(smem + 66560) + (uc & 1) * 256; LAS float* roww = (LAS float*)(rowpair + 128);
        if (e < 16 && tidx() < 128) { const int pos = mt * 128 + tidx(); int pr = 0; float w = 0.f; if (pos < cnt) { pr = p.elist[(size_t)e * NT + pos]; w = p.ewt[pr]; } rowpair[tidx()] = pr; roww[tidx()] = w; }
        ++uc;
        f32x4 acc[4][4]; zero_acc(acc);
        gemm_tile<false>(acc, A, [&](int r) { const int rr = (mt * 128 + r < cnt) ? r : 0; return rr * 256; }, p.W2T + ((size_t)e * DM + nt * 128) * 256, 256, 256, smem, pre,
            [&]() { if (hasn) gemm_prestage<4>(An, [&](int r) { const int rr = (mtn * 128 + r < cntn) ? r : 0; return rr * 256; }, Bn, 256, smem); });
        pre = hasn;
        for_frags(acc, [&](int r, int c, f32x4 lo, f32x4 hi) { const int pos = mt * 128 + r; if (pos < cnt) {
            if (e < 16) { const int pair = rowpair[r]; const float w = roww[r]; store_bf8(SLOT + (size_t)pair * DM + nt * 128 + c, lo * w, hi * w); }
            else store_bf8(SHOUT + (size_t)sh_tok(l, pos) * DM + nt * 128 + c, lo, hi); } });
        u = un;
    }
}
DI void ph_final(const Params& p, int l, bool dry = false) {
    const int lane = tidx() & 63, gw = bidx() * 4 + (tidx() >> 6), nw = gdim() * 4;
    const bf16_t* SLOT = p.P; const bf16_t* SHOUT = p.H;
    auto active = [&](int tok) { return tok < NT && !(l == 1 && tok_s(tok) < CTXL); };
    u32x2 a0[4], a1[4], a2[4], b0[4], b1[4], b2[4]; f32x4 xv[4], xn[4];
    auto load = [&](int tok, u32x2 (&q0)[4], u32x2 (&q1)[4], u32x2 (&q2)[4], f32x4 (&x)[4]) {
        const float* xd = xrow_dst(p, tok);
#pragma unroll
        for (int i = 0; i < 4; ++i) { const int d = lane * 4 + 256 * i;
            q0[i] = *(const u32x2*)(SLOT + (size_t)tok * 2 * DM + d); q1[i] = *(const u32x2*)(SLOT + (size_t)tok * 2 * DM + DM + d); q2[i] = *(const u32x2*)(SHOUT + (size_t)tok * DM + d);
            x[i] = *(const f32x4*)(xd + d); }
    };
    auto up = [](u32x2 r) { f32x4 o; o[0] = __uint_as_float(r[0] << 16); o[1] = __uint_as_float(r[0] & 0xffff0000u); o[2] = __uint_as_float(r[1] << 16); o[3] = __uint_as_float(r[1] & 0xffff0000u); return o; };
    if (active(gw)) load(gw, a0, a1, a2, xv);
    for (int tok = gw; tok < NT; tok += nw) {
        const int nxt = tok + nw; const bool an = active(nxt);
        if (an) load(nxt, b0, b1, b2, xn);
        if (active(tok)) {
            float* xd = xrow_dst(p, tok); const float* g2 = mod_row(p, l, tok, 5);
            f32x4 m[4]; float ss = 0.f;
#pragma unroll
            for (int i = 0; i < 4; ++i) { m[i] = up(a0[i]) + up(a1[i]) + up(a2[i]); ss += m[i][0] * m[i][0] + m[i][1] * m[i][1] + m[i][2] * m[i][2] + m[i][3] * m[i][3]; }
            ss = wave_sum(ss); const float rstd = rsqrtf(ss * (1.f / DM) + EPS);
#pragma unroll
            for (int i = 0; i < 4; ++i) { const int d = lane * 4 + 256 * i; const f32x4 gp = *(const f32x4*)(p.g_post2 + (size_t)l * DM + d), gt = *(const f32x4*)(g2 + d);
                f32x4 o;
#pragma unroll
                for (int j = 0; j < 4; ++j) o[j] = xv[i][j] + gt[j] * (m[i][j] * rstd * gp[j]);
                *(f32x4*)((dry ? (float*)p.Y + (size_t)(tok & 8191) * DM : xd) + d) = o; m[i] = o; }
            if (l == 0 && !dry) {
                float s2 = 0.f;
#pragma unroll
                for (int i = 0; i < 4; ++i) s2 += m[i][0] * m[i][0] + m[i][1] * m[i][1] + m[i][2] * m[i][2] + m[i][3] * m[i][3];
                s2 = wave_sum(s2); const float r2 = rsqrtf(s2 * (1.f / DM) + EPS);
                const float* sh = mod_row(p, 1, tok, 0); const float* scl = mod_row(p, 1, tok, 1); const float* g = p.g_pre1 + DM;
#pragma unroll
                for (int i = 0; i < 4; ++i) { const int d = lane * 4 + 256 * i; const f32x4 gg = *(const f32x4*)(g + d), s1 = *(const f32x4*)(scl + d), s0 = *(const f32x4*)(sh + d);
                    f32x4 hq;
#pragma unroll
                    for (int j = 0; j < 4; ++j) hq[j] = m[i][j] * r2 * gg[j] * (1.f + s1[j]) + s0[j];
                    store_bf4(p.H + (size_t)tok * DM + d, hq); }
            }
        }
#pragma unroll
        for (int i = 0; i < 4; ++i) { a0[i] = b0[i]; a1[i] = b1[i]; a2[i] = b2[i]; xv[i] = xn[i]; }
    }
}

constexpr int SMEM_BYTES = 68608;
#if MK_ONE_LAUNCH
DI void gbar(const XcdBarrier& b0) { XcdBarrier b = b0; asm volatile("" : "+s"(b.bar), "+s"(b.x)); xcd_barrier(b); }
__global__ void __launch_bounds__(NTHR, 2) k_fwd(Params pk) {
    extern __shared__ __attribute__((aligned(16))) char smem_[];
    LAS char* smem = (LAS char*)smem_;
    if (threadIdx.x < 4) ((LAS unsigned*)(smem + SMEM_BYTES))[threadIdx.x] = 0u;
    __syncthreads();
    XcdBarrier bar = xcd_barrier_post(pk.bar, (volatile LAS unsigned*)(smem + SMEM_BYTES));
    ph_adaln(pk, smem); __syncthreads(); ph_convert(pk, 0, smem); ph_rot_table(pk);
    gbar(bar);
    for (int l = 0; l < 2; ++l) {
        if (l == 0) { ph_norm1(pk, l);            gbar(bar); }
        for (int rep = 0; rep < REP_INPROJ; ++rep) { ph_inproj(pk, smem);        gbar(bar); }
        if (DRY_PREP) { ph_prep(pk, l, smem, true); gbar(bar); }
        ph_prep(pk, l, smem);       gbar(bar);
        for (int rep = 0; rep < REP_LOCAL; ++rep) { ph_local(pk, l, smem);      gbar(bar); }
        ph_scan2(pk, l, smem);            gbar(bar);
        if (!RET_NEW || !DN_NEW) { ph_fin(pk, l); gbar(bar); }
        for (int rep = 0; rep < REP_OUTPUT; ++rep) { ph_output(pk, l, smem);     gbar(bar); }
        if (l == 1) { ph_norm1(pk, l);            gbar(bar); }
        for (int rep = 0; rep < REP_MERGE; ++rep) { ph_merge(pk, l, smem);      gbar(bar); }
        for (int rep = 0; rep < REP_WOUT; ++rep) { ph_wout(pk, l, smem);       gbar(bar); }
        if (DRY_R2) { ph_r2(pk, l, smem, true); gbar(bar); }
        ph_r2(pk, l, smem);               gbar(bar);
        for (int rep = 0; rep < REP_MOE; ++rep) { ph_moe1(pk, l, smem);       gbar(bar); }
        for (int rep = 0; rep < REP_MOE; ++rep) { ph_moe2(pk, l, smem);       gbar(bar); }
        if (DRY_FINAL) { ph_final(pk, l, true); gbar(bar); }
        ph_final(pk, l);
        if (l == 0) { __syncthreads(); ph_convert(pk, 1, smem); gbar(bar); }
    }
}
#else
template <int PH>
__global__ void __launch_bounds__(NTHR, 2) k_phase(Params pk, int l) {
    extern __shared__ __attribute__((aligned(16))) char smem_[];
    LAS char* smem = (LAS char*)smem_;
    if (PH == 0) { ph_adaln(pk, smem); __syncthreads(); ph_convert(pk, 0, smem); ph_rot_table(pk); }
    if (PH == 1) ph_norm1(pk, l);
    if (PH == 2) ph_inproj(pk, smem);
    if (PH == 3) ph_prep(pk, l, smem);
    if (PH == 4) ph_local(pk, l, smem);
    if (PH == 13) ph_scan2(pk, l, smem);
    if (PH == 5) ph_fin(pk, l);
    if (PH == 6) ph_output(pk, l, smem);
    if (PH == 7) ph_merge(pk, l, smem);
    if (PH == 8) ph_wout(pk, l, smem);
    if (PH == 9) ph_r2(pk, l, smem);
    if (PH == 10) ph_moe1(pk, l, smem);
    if (PH == 11) ph_moe2(pk, l, smem);
    if (PH == 12) { ph_final(pk, l); if (l == 0) { __syncthreads(); ph_convert(pk, 1, smem); } }
}
#endif

static size_t al256(size_t x) { return (x + 255) & ~(size_t)255; }
extern "C" void kernel_launch(void* const* d_in, const int* in_sizes, int n_in, void* d_out, int out_size, void* d_ws, size_t ws_size, hipStream_t stream) {
    Params p{};
    const float** fp = (const float**)&p.x;
    for (int i = 0; i < 33; ++i) fp[i] = (const float*)d_in[i];
    p.out = (float*)d_out;
    char* w = (char*)d_ws; size_t o = 0;
    auto take = [&](size_t bytes) { char* r = w + o; o = al256(o + bytes); return r; };
    p.bar = (unsigned*)take(16384);
    p.cnt = (int*)take(256);
    p.mod = (float*)take((size_t)2 * 5 * 6 * DM * 4);
    p.xc = (float*)take((size_t)NB * CTXL * DM * 4);
    p.WinT = (bf16_t*)take((size_t)INC * DM * 2);
    p.WbrT = (bf16_t*)take((size_t)4 * DM * 256 * 2);
    p.WoutT = (bf16_t*)take((size_t)DM * DM * 2);
    p.W1T = (bf16_t*)take((size_t)17 * 256 * DM * 2);
    p.W3T = (bf16_t*)take((size_t)17 * 256 * DM * 2);
    p.W2T = (bf16_t*)take((size_t)17 * DM * 256 * 2);
    p.WuqT = (bf16_t*)take((size_t)384 * 256 * 2);
    p.WukvT = (bf16_t*)take((size_t)512 * 128 * 2);
    p.H = (bf16_t*)take((size_t)NT * DM * 2);
    p.P = (bf16_t*)take((size_t)NT * PW * 2);
    p.DNRAW = (bf16_t*)take((size_t)NT * 768 * 2);
    p.RS = p.DNRAW; p.DNM = p.DNRAW + (size_t)32 * NCHUNK * 4096; p.DNN = p.DNRAW + (size_t)64 * NCHUNK * 4096;
    p.DNQKV = (bf16_t*)take((size_t)NT * 768 * 2);
    p.Y = (bf16_t*)take((size_t)NT * DM * 2);
    p.MQ = (bf16_t*)take((size_t)NT * 384 * 2);
    p.MK = (bf16_t*)take((size_t)NT * 384 * 2);
    p.MVT = (bf16_t*)take((size_t)NT * 256 * 2);
    p.DG = (float*)take((size_t)NT * 8 * 4);
    p.DB = (float*)take((size_t)NT * 8 * 4);
    p.ewt = (float*)take((size_t)NT * 2 * 4);
    p.elist = (int*)take((size_t)16 * NT * 4);
    p.DSP = (bf16_t*)take((size_t)32 * NCHUNK * 4096 * 2);
    p.SGW = (bf16_t*)take((size_t)4 * 128 * 128 * 2);
    p.ROT = (float*)take((size_t)SEQ * 32 * 2 * 4 + 128 * 8 * 2 * 4);
    if (o > ws_size) { fprintf(stderr, "workspace too small: need %zu have %zu\n", o, ws_size); return; }
#if MK_ONE_LAUNCH
    static int grid = 0;
    if (!grid) {
        int dev = 0, cus = 0, per_cu = 0;
        hipGetDevice(&dev);
        hipDeviceGetAttribute(&cus, hipDeviceAttributeMultiprocessorCount, dev);
        hipFuncSetAttribute((const void*)k_fwd, hipFuncAttributeMaxDynamicSharedMemorySize, SMEM_BYTES + 16);
        hipOccupancyMaxActiveBlocksPerMultiprocessor(&per_cu, k_fwd, NTHR, SMEM_BYTES + 16);
        if (per_cu > 2) per_cu = 2;
        if (per_cu < 1) per_cu = 1;
        grid = cus * per_cu;
    }
    hipMemsetAsync(p.bar, 0, 16384, stream);
    k_fwd<<<grid, NTHR, SMEM_BYTES + 16, stream>>>(p);
#else
    const int G = 512;
    k_phase<0><<<G, NTHR, SMEM_BYTES + 16, stream>>>(p, 0);
    for (int l = 0; l < 2; ++l) {
        k_phase<1><<<G, NTHR, SMEM_BYTES + 16, stream>>>(p, l);
        k_phase<2><<<G, NTHR, SMEM_BYTES + 16, stream>>>(p, l);
        k_phase<3><<<G, NTHR, SMEM_BYTES + 16, stream>>>(p, l);
        k_phase<4><<<G, NTHR, SMEM_BYTES + 16, stream>>>(p, l);
        k_phase<13><<<G, NTHR, SMEM_BYTES + 16, stream>>>(p, l);
        if (!RET_NEW || !DN_NEW) k_phase<5><<<G, NTHR, SMEM_BYTES + 16, stream>>>(p, l);
        k_phase<6><<<G, NTHR, SMEM_BYTES + 16, stream>>>(p, l);
        k_phase<1><<<G, NTHR, SMEM_BYTES + 16, stream>>>(p, l);
        k_phase<7><<<G, NTHR, SMEM_BYTES + 16, stream>>>(p, l);
        k_phase<8><<<G, NTHR, SMEM_BYTES + 16, stream>>>(p, l);
        k_phase<9><<<G, NTHR, SMEM_BYTES + 16, stream>>>(p, l);
        k_phase<10><<<G, NTHR, SMEM_BYTES + 16, stream>>>(p, l);
        k_phase<11><<<G, NTHR, SMEM_BYTES + 16, stream>>>(p, l);
        k_phase<12><<<G, NTHR, SMEM_BYTES + 16, stream>>>(p, l);
    }
#endif
}
```
